# Optimizing an MI355X kernel written in HIP

```python
import jax, jax.numpy as jnp
from jax import lax
import numpy as np

D_MODEL = 1024
BATCH = 16
SEQ = 4096
DEPTH = 2
DEC_BATCH = 8
DEC_SEQ = 16
PAST_LEN = 2048

CHUNK = 64
GMLP_CHUNK = 128
D_A = D_MODEL
A_GROUPS = 8
A_GROUP_W = D_A // A_GROUPS
B_HEADS = 8
B_DK = 128
B_DV = 128
D_B = B_HEADS * B_DV
CONV_W = 4
D_FF = 4 * D_MODEL
EPS = 1e-6
SPLIT_SIZES = (D_A, D_A, 3 * D_B, D_B, B_HEADS, B_HEADS, D_MODEL, D_MODEL)
N_IN = sum(SPLIT_SIZES)

kernel_name = "gmlp_gated_deltanet_streaming_encoder"


def rmsnorm(x, g):
    xf = x.astype(jnp.float32)
    y = xf * lax.rsqrt(jnp.mean(xf * xf, axis=-1, keepdims=True) + EPS)
    return (y * g.astype(jnp.float32)).astype(x.dtype)


def layernorm(x, g, b):
    xf = x.astype(jnp.float32)
    mu = jnp.mean(xf, axis=-1, keepdims=True)
    var = jnp.mean(jnp.square(xf - mu), axis=-1, keepdims=True)
    y = (xf - mu) * lax.rsqrt(var + EPS)
    return (y * g.astype(jnp.float32) + b.astype(jnp.float32)).astype(x.dtype)


def l2norm(x):
    return x * lax.rsqrt(jnp.sum(x * x, axis=-1, keepdims=True) + EPS)


def causal_conv(x, prev, w):
    L = x.shape[1]
    xp = jnp.concatenate([prev.astype(x.dtype), x], axis=1)
    y = xp[:, 0:L] * w[:, 0]
    for j in range(1, CONV_W):
        y = y + xp[:, j:j + L] * w[:, j]
    return y, xp[:, -(CONV_W - 1):]


def gmlp_spatial(vn, w_s, b_s):
    B, L, _ = vn.shape
    c = min(L, GMLP_CHUNK)
    n = L // c
    mask = jnp.tril(jnp.ones((c, c), dtype=bool))
    w = jnp.where(mask, w_s[:, :c, :c], 0.0).astype(vn.dtype)
    v5 = vn.reshape(B, n, c, A_GROUPS, A_GROUP_W)
    s = jnp.einsum('gts,bnsgc->bntgc', w, v5)
    s = s + jnp.transpose(b_s[:, :c])[None, None, :, :, None].astype(vn.dtype)
    return s.reshape(B, L, D_A)


def gated_delta_rule(q, k, v, g, beta, s0):
    B, L, H, _ = q.shape
    c = min(L, CHUNK)
    n = L // c
    qb = q.reshape(B, n, c, H, B_DK).transpose(1, 0, 3, 2, 4)
    kb_ = k.reshape(B, n, c, H, B_DK).transpose(1, 0, 3, 2, 4)
    vb = v.reshape(B, n, c, H, B_DV).transpose(1, 0, 3, 2, 4)
    gb = g.reshape(B, n, c, H).transpose(1, 0, 3, 2)
    bb = beta.reshape(B, n, c, H).transpose(1, 0, 3, 2)
    gam = jnp.cumsum(gb, axis=-1)
    causal = jnp.tril(jnp.ones((c, c), dtype=bool))
    strict = jnp.tril(jnp.ones((c, c), dtype=bool), -1)
    decay = jnp.exp(jnp.where(causal, gam[..., :, None] - gam[..., None, :], -jnp.inf))
    k_beta = kb_ * bb[..., None]
    A = jnp.where(strict, jnp.einsum('nbhid,nbhjd->nbhij', k_beta, kb_) * decay, 0.0)
    T = A + jnp.eye(c, dtype=A.dtype)
    U = lax.linalg.triangular_solve(T, vb * bb[..., None], left_side=True, lower=True, unit_diagonal=True)
    W = lax.linalg.triangular_solve(T, k_beta * jnp.exp(gam)[..., None], left_side=True, lower=True, unit_diagonal=True)
    P = jnp.einsum('nbhid,nbhjd->nbhij', qb, kb_) * decay
    qg = qb * jnp.exp(gam)[..., None]
    kg = kb_ * jnp.exp(gam[..., -1:] - gam)[..., None]
    glast = jnp.exp(gam[..., -1])

    def step(S, xs):
        U_, W_, P_, qg_, kg_, gl_ = xs
        vnew = U_ - jnp.einsum('bhcd,bhde->bhce', W_, S)
        o = jnp.einsum('bhcd,bhde->bhce', qg_, S) + jnp.einsum('bhij,bhje->bhie', P_, vnew)
        S = S * gl_[..., None, None] + jnp.einsum('bhcd,bhce->bhde', kg_, vnew)
        return S, o

    S, o = lax.scan(step, s0, (U, W, P, qg, kg, glast))
    o = o.transpose(1, 0, 3, 2, 4).reshape(B, L, H, B_DV)
    return o, S


def trunk_layer(x, conv_prev, s0, ln1, w_in, a_ln_g, a_ln_b, w_s, b_s, conv_w, a_log, dt_bias,
                o_norm, p_a, p_b, w_o, ln2, w_up, w_down):
    B, L, _ = x.shape
    h = rmsnorm(x, ln1)
    proj = h @ w_in
    idx = list(np.cumsum(SPLIT_SIZES)[:-1])
    u, va, qkv, z, b_raw, a_raw, ga, gb = jnp.split(proj, idx, axis=-1)

    u = jax.nn.gelu(u, approximate=False)
    vn = layernorm(jax.nn.gelu(va, approximate=False), a_ln_g, a_ln_b)
    z_a = u * gmlp_spatial(vn, w_s, b_s)

    qkv, conv_state = causal_conv(qkv, conv_prev, conv_w)
    qkv = jax.nn.silu(qkv).astype(jnp.float32)
    q, k, v = jnp.split(qkv, 3, axis=-1)
    q = l2norm(q.reshape(B, L, B_HEADS, B_DK)) * (B_DK ** -0.5)
    k = l2norm(k.reshape(B, L, B_HEADS, B_DK))
    v = v.reshape(B, L, B_HEADS, B_DV)
    beta = jax.nn.sigmoid(b_raw.astype(jnp.float32))
    g = -jnp.exp(a_log.astype(jnp.float32)) * jax.nn.softplus(a_raw.astype(jnp.float32) + dt_bias.astype(jnp.float32))
    o, S = gated_delta_rule(q, k, v, g, beta, s0.astype(jnp.float32))
    o = rmsnorm(o, o_norm) * jax.nn.silu(z.astype(jnp.float32).reshape(B, L, B_HEADS, B_DV))
    z_b = o.reshape(B, L, D_B).astype(x.dtype)

    mix = jax.nn.sigmoid(ga) * (z_a @ p_a) + jax.nn.sigmoid(gb) * (z_b @ p_b)
    x = x + mix @ w_o
    h2 = rmsnorm(x, ln2)
    x = x + jnp.square(jax.nn.relu(h2 @ w_up)) @ w_down
    return x, conv_state, S.astype(x.dtype), vn


def setup_inputs(seed: int = 0) -> dict:
    key = jax.random.key(seed)
    ks = jax.random.split(key, 24)
    f32 = jnp.float32
    nrm = lambda k, shape, s: jax.random.normal(k, shape, f32) * s
    dt = jnp.exp(jax.random.uniform(ks[13], (DEPTH, B_HEADS), f32, np.log(1e-3), np.log(1e-1)))
    return {
        "x_prompt": nrm(ks[0], (BATCH, SEQ, D_MODEL), 1.0),
        "x_sample": nrm(ks[1], (DEC_BATCH, DEC_SEQ, D_MODEL), 1.0),
        "state_conv": nrm(ks[2], (DEPTH, DEC_BATCH, CONV_W - 1, 3 * D_B), 1.0),
        "state_delta": nrm(ks[3], (DEPTH, DEC_BATCH, B_HEADS, B_DK, B_DV), 0.1),
        "ln1": 1.0 + nrm(ks[4], (DEPTH, D_MODEL), 0.02),
        "w_in": nrm(ks[5], (DEPTH, D_MODEL, N_IN), D_MODEL ** -0.5),
        "a_ln_g": 1.0 + nrm(ks[6], (DEPTH, D_A), 0.02),
        "a_ln_b": nrm(ks[7], (DEPTH, D_A), 0.02),
        "w_s": nrm(ks[8], (DEPTH, A_GROUPS, GMLP_CHUNK, GMLP_CHUNK), 0.5 * GMLP_CHUNK ** -0.5),
        "b_s": 1.0 + nrm(ks[9], (DEPTH, A_GROUPS, GMLP_CHUNK), 0.02),
        "conv_w": nrm(ks[10], (DEPTH, 3 * D_B, CONV_W), 0.5),
        "a_log": jnp.log(jax.random.uniform(ks[11], (DEPTH, B_HEADS), f32, 1.0, 16.0)),
        "dt_bias": dt + jnp.log(-jnp.expm1(-dt)),
        "o_norm": 1.0 + nrm(ks[12], (DEPTH, B_DV), 0.02),
        "p_a": nrm(ks[14], (DEPTH, D_A, D_MODEL), D_A ** -0.5),
        "p_b": nrm(ks[15], (DEPTH, D_B, D_MODEL), D_B ** -0.5),
        "w_o": nrm(ks[16], (DEPTH, D_MODEL, D_MODEL), D_MODEL ** -0.5),
        "ln2": 1.0 + nrm(ks[17], (DEPTH, D_MODEL), 0.02),
        "w_up": nrm(ks[18], (DEPTH, D_MODEL, D_FF), D_MODEL ** -0.5),
        "w_down": nrm(ks[19], (DEPTH, D_FF, D_MODEL), 0.5 * D_FF ** -0.5),
        "final_norm": 1.0 + nrm(ks[20], (D_MODEL,), 0.02),
    }


def reference(x_prompt, x_sample, state_conv, state_delta, ln1, w_in, a_ln_g, a_ln_b, w_s, b_s,
              conv_w, a_log, dt_bias, o_norm, p_a, p_b, w_o, ln2, w_up, w_down, final_norm):
    yp, ys = x_prompt, x_sample
    conv_p, delta_p, conv_s, delta_s, gv_s = [], [], [], [], []
    zero_conv = jnp.zeros((x_prompt.shape[0], CONV_W - 1, 3 * D_B), x_prompt.dtype)
    zero_delta = jnp.zeros((x_prompt.shape[0], B_HEADS, B_DK, B_DV), jnp.float32)
    for l in range(DEPTH):
        params = (ln1[l], w_in[l], a_ln_g[l], a_ln_b[l], w_s[l], b_s[l], conv_w[l], a_log[l], dt_bias[l],
                  o_norm[l], p_a[l], p_b[l], w_o[l], ln2[l], w_up[l], w_down[l])
        yp, cp, dp, _ = trunk_layer(yp, zero_conv, zero_delta, *params)
        ys, cs, ds, vs = trunk_layer(ys, state_conv[l], state_delta[l], *params)
        conv_p.append(cp); delta_p.append(dp); conv_s.append(cs); delta_s.append(ds); gv_s.append(vs)
    y_prompt = rmsnorm(yp, final_norm)
    y_sample = rmsnorm(ys, final_norm)
    new_conv_prompt = jnp.stack(conv_p)
    new_delta_prompt = jnp.stack(delta_p)
    new_conv_sample = jnp.stack(conv_s)
    new_delta_sample = jnp.stack(delta_s)
    new_gmlp_v_sample = jnp.stack(gv_s)
    return (y_prompt, y_sample, new_conv_prompt, new_delta_prompt, new_conv_sample, new_delta_sample, new_gmlp_v_sample)
```

```cpp
#include <hip/hip_runtime.h>
#include <hip/hip_cooperative_groups.h>
#include <cstdio>
namespace cg = cooperative_groups;

#define LAS __attribute__((address_space(3)))
typedef unsigned short bf16_t;
typedef short bf16x8 __attribute__((ext_vector_type(8)));
typedef float f32x4 __attribute__((ext_vector_type(4)));
typedef float f32x2 __attribute__((ext_vector_type(2)));
typedef unsigned u32x4 __attribute__((ext_vector_type(4)));
typedef unsigned u32x2 __attribute__((ext_vector_type(2)));

constexpr int DM = 1024, NIN = 8208, NPROJ = 8448, DFF = 4096;
constexpr int TGMAX = 33024;
constexpr int NTHREADS = 512;
constexpr float EPS = 1e-6f;
constexpr size_t SLOT_EL = (size_t)TGMAX * 1024;
constexpr size_t W_IN = 0, W_PA = W_IN + (size_t)NPROJ * 1024, W_PB = W_PA + 1048576, W_WO = W_PB + 1048576,
                 W_UP = W_WO + 1048576, W_DN = W_UP + 4194304, W_LAYER = W_DN + 4194304;
constexpr int NUNITS = 520 * 8;
constexpr size_t WS_W = 0;
constexpr size_t WS_XB = WS_W + 2 * W_LAYER * 2;
constexpr size_t WS_ACT = WS_XB + SLOT_EL * 2;
constexpr size_t WS_KGT = WS_ACT + 8 * SLOT_EL * 2;
constexpr size_t WS_O = WS_KGT + (size_t)NUNITS * 8192 * 2;
constexpr size_t WS_P = WS_O + (size_t)NUNITS * 8192 * 2;
constexpr size_t WS_HALO = WS_P + (size_t)NUNITS * 4096 * 2;
constexpr size_t WS_BG = WS_HALO + (size_t)516 * 3 * 3072 * 2;
constexpr size_t WS_GL = WS_BG + (size_t)TGMAX * 16 * 4;
constexpr size_t WS_RS = WS_GL + 32768;
constexpr size_t WS_ZB = WS_RS + (size_t)10 * TGMAX * 4;
constexpr size_t WS_BAR = WS_ZB + SLOT_EL * 2;
constexpr size_t WS_END = WS_BAR + 16384;
constexpr size_t OY_P = 0, OY_S = 67108864, OCP = 67239936, ODP = 67534848, OCS = 71729152, ODS = 71876608, OGV = 73973760;
constexpr int LDS_BYTES = 147456;

struct Params { const float* in[21]; float* out; unsigned char* ws; };


typedef const __attribute__((address_space(4))) char* kaptr_t;
__device__ __forceinline__ kaptr_t ka_base() { kaptr_t ka = (kaptr_t)__builtin_amdgcn_kernarg_segment_ptr(); asm volatile("" : "+s"(ka)); return ka; }
#define INP(i) (*(const float* const __attribute__((address_space(4)))*)(ka_base() + 8 * (i)))
#define OUTP() (*(float* const __attribute__((address_space(4)))*)(ka_base() + 8 * 21))
#define WSP() (*(unsigned char* const __attribute__((address_space(4)))*)(ka_base() + 8 * 22))

typedef __bf16 bf16v2_t __attribute__((ext_vector_type(2)));
__device__ __forceinline__ unsigned cvt_pk_bf16(float lo, float hi) { const f32x2 v = {lo, hi}; const bf16v2_t b = __builtin_convertvector(v, bf16v2_t); return __builtin_bit_cast(unsigned, b); }
__device__ __forceinline__ bf16_t f2bf(float f) { return (bf16_t)(cvt_pk_bf16(f, 0.f) & 0xffffu); }
__device__ __forceinline__ float bf2f(bf16_t b) { return __uint_as_float(((unsigned)b) << 16); }
__device__ __forceinline__ float bflo(unsigned w) { return __uint_as_float(w << 16); }
__device__ __forceinline__ float bfhi(unsigned w) { return __uint_as_float(w & 0xffff0000u); }
__device__ __forceinline__ float sigmoidf_(float x) { return __builtin_amdgcn_rcpf(1.0f + __builtin_amdgcn_exp2f(x * -1.44269504089f)); }
__device__ __forceinline__ float siluf_(float x) { return x * __builtin_amdgcn_rcpf(1.0f + __builtin_amdgcn_exp2f(x * -1.44269504089f)); }
__device__ __forceinline__ f32x2 gelu_pk(f32x2 v) {
    const f32x2 av = __builtin_elementwise_abs(v), d = av * 0.2316418882f + 1.0f;
    f32x2 t; t.x = __builtin_amdgcn_rcpf(d.x); t.y = __builtin_amdgcn_rcpf(d.y);
    f32x2 q = t * 0.5307027145f + (-0.7265760135f); q = q * t + 0.7107068705f; q = q * t + (-0.142248368f); q = q * t + 0.127414796f; q = q * t;
    const f32x2 s = (v * v) * (-0.72134752044f);
    f32x2 e; e.x = __builtin_amdgcn_exp2f(s.x); e.y = __builtin_amdgcn_exp2f(s.y);
    const f32x2 m = v * (q * e), r = v - m;
    f32x2 o; o.x = v.x < 0.f ? m.x : r.x; o.y = v.y < 0.f ? m.y : r.y; return o;
}
__device__ __forceinline__ float wave_sum(float v) {
#pragma unroll
    for (int o = 32; o >= 1; o >>= 1) v += __shfl_xor(v, o);
    return v;
}
__device__ __forceinline__ bool row_valid(int g, int r) { return r < 32768 || (g == 0 && r < 32896); }
__device__ __forceinline__ float* yrow(float* out, int g, int r) { return r < 32768 ? out + OY_P + ((size_t)g * 32768 + r) * 1024 : out + OY_S + (size_t)(r - 32768) * 1024; }

namespace pg8 {
constexpr int BM = 256, BK = 64, HALF = 128, HTB = HALF * BK * 2, STAGE_BYTES = 8 * HTB, NXCD = 8, WGM = 8;
__device__ __forceinline__ int lds_byte(int r, int c) { const int st = (r >> 4) * 2 + (c >> 5), rr = r & 15, cc = c & 31, ob = rr * 64 + cc * 2; return st * 1024 + (ob ^ (((ob >> 9) & 1) << 5)); }
__device__ __forceinline__ void stage_rc(int b, int& R, int& C) { const int st = b / 1024, sb = b % 1024, swz = sb ^ (((sb >> 9) & 1) << 5); R = (st >> 1) * 16 + swz / 64; C = (st & 1) * 32 + (swz % 64) / 2; }
__device__ __forceinline__ int perm32(int rho) { const int n = rho >> 4, i = rho & 15; return 8 * (i >> 2) + 4 * n + (i & 3); }
struct Unit { int pm, pn; };
struct Gemm { const bf16_t* A; const bf16_t* Bt; int M, N, K; };
struct StaticOrder {
    int nM, nN, nwg, G, c;
    __device__ void init(int M, int N, int G_, int c_) { nM = M / BM; nN = N / BM; nwg = nM * nN; G = G_; c = c_; }
    __device__ bool next(int i, Unit& u) const {
        const long L = (long)i * G + c; if (L >= nwg) return false;
        int wgid = (int)L; { const int q = nwg / NXCD, r = nwg % NXCD, xcd = wgid % NXCD, off = wgid / NXCD; wgid = (xcd < r ? xcd * (q + 1) : r * (q + 1) + (xcd - r) * q) + off; }
        const int nig = WGM * nN, gid = wgid / nig, fm = gid * WGM, gsz = (nM - fm) < WGM ? (nM - fm) : WGM;
        u.pm = fm + ((wgid % nig) % gsz); u.pn = (wgid % nig) / gsz; return true;
    }
};
template <class Epi>
__device__ __forceinline__ void gemm_phase(LAS unsigned char* lds, const Gemm g, const StaticOrder& S, const Epi& E, const int tidx) {
    const int tid = tidx, wid = __builtin_amdgcn_readfirstlane(tid >> 6), lane = tid & 63, wr = wid >> 2, wc = wid & 3, fr = lane & 15, fq = lane >> 4;
    const int K = g.K, nt = K / BK;
    unsigned voffA[2], voffB[2];
#pragma unroll
    for (int i = 0; i < 2; ++i) { int R, C; stage_rc(tid * 16 + i * 8192, R, C); const int Rb = E.perm() ? ((R & ~31) + perm32(R & 31)) : R;
        voffA[i] = (unsigned)(R * K + C) * 2u; voffB[i] = (unsigned)(Rb * K + C) * 2u; }
    const size_t kstep = (size_t)(BK * 2);
    const size_t hstep = (size_t)HALF * K * 2;
    const size_t tstep = 2 * hstep;
    const unsigned ldsw = (unsigned)wid * 1024u;
    const int aoff = lds_byte(wr * 64 + fr, fq * 8), boff = lds_byte(wc * 32 + fr, fq * 8);
#define PG8_SA(b, h) (((b) * 2 + (h)) * HTB)
#define PG8_SB(b, h) ((4 + (b) * 2 + (h)) * HTB)
#define PG8_STAGE(bufoff, gbase, voff) do { _Pragma("unroll") for (int _i = 0; _i < 2; ++_i) \
        __builtin_amdgcn_global_load_lds((const unsigned*)((const char*)(gbase) + (voff)[_i]), (LAS unsigned*)(lds + (bufoff) + ldsw + _i * 8192), 16, 0, 0); } while (0)
#define PG8_LDA(dst, b, h) do { _Pragma("unroll") for (int m = 0; m < 4; ++m) _Pragma("unroll") for (int k = 0; k < 2; ++k) dst[m][k] = *(const LAS bf16x8*)(lds + PG8_SA(b, h) + aoff + m * 2048 + k * 1024); } while (0)
#define PG8_LDB(dst, b, h) do { _Pragma("unroll") for (int n = 0; n < 2; ++n) _Pragma("unroll") for (int k = 0; k < 2; ++k) dst[n][k] = *(const LAS bf16x8*)(lds + PG8_SB(b, h) + boff + n * 2048 + k * 1024); } while (0)
#define PG8_MMA(ai, bj, At, Bt) do { __builtin_amdgcn_s_setprio(1); _Pragma("unroll") for (int m = 0; m < 4; ++m) _Pragma("unroll") for (int n = 0; n < 2; ++n) _Pragma("unroll") for (int k = 0; k < 2; ++k) \
        acc[ai][bj][m][n] = __builtin_amdgcn_mfma_f32_16x16x32_bf16(Bt[n][k], At[m][k], acc[ai][bj][m][n], 0, 0, 0); __builtin_amdgcn_s_setprio(0); } while (0)
#define PG8_WAIT_V(n) asm volatile("s_waitcnt vmcnt(" #n ")" ::: "memory")
#define PG8_WAIT_L(n) asm volatile("s_waitcnt lgkmcnt(" #n ")" ::: "memory")
#define PG8_BAR __builtin_amdgcn_s_barrier()
#define PG8_SCHED __builtin_amdgcn_sched_barrier(0)
    Unit cur, nxt; int ui = 0;
    if (!S.next(0, cur)) return;
    f32x4 acc[2][2][4][2];
#pragma unroll
    for (int a = 0; a < 2; ++a)
#pragma unroll
        for (int b = 0; b < 2; ++b)
#pragma unroll
            for (int m = 0; m < 4; ++m)
#pragma unroll
                for (int n = 0; n < 2; ++n) acc[a][b][m][n] = (f32x4){0.f, 0.f, 0.f, 0.f};
    bf16x8 At[4][2], B0[2][2], B1[2][2];
    const char* cA = (const char*)g.A + (size_t)cur.pm * tstep; const char* cB = (const char*)g.Bt + (size_t)cur.pn * tstep;
    PG8_STAGE(PG8_SB(0, 0), cB, voffB); PG8_STAGE(PG8_SA(0, 0), cA, voffA); PG8_STAGE(PG8_SB(0, 1), cB + hstep, voffB); PG8_STAGE(PG8_SA(0, 1), cA + hstep, voffA);
    if (wr == 1) PG8_BAR;
    PG8_WAIT_V(4); PG8_BAR;
    PG8_STAGE(PG8_SB(1, 0), cB + kstep, voffB); PG8_STAGE(PG8_SA(1, 0), cA + kstep, voffA); PG8_STAGE(PG8_SB(1, 1), cB + hstep + kstep, voffB);
    PG8_WAIT_V(6); PG8_BAR;
    for (;;) {
        const bool has_next = S.next(ui + 1, nxt);
        const char* nA = has_next ? (const char*)g.A + (size_t)nxt.pm * tstep : cA; const char* nB = has_next ? (const char*)g.Bt + (size_t)nxt.pn * tstep : cB;
        for (int t = 0; t < nt; t += 2) {
            const bool last = (t == nt - 2);
            const char* a1 = cA + (size_t)(t + 1) * kstep;
            const char* a2 = last ? nA : cA + (size_t)(t + 2) * kstep; const char* b2 = last ? nB : cB + (size_t)(t + 2) * kstep;
            const char* a3 = a2 + kstep; const char* b3 = b2 + kstep;
            PG8_LDB(B0, 0, 0); PG8_SCHED; PG8_LDA(At, 0, 0); PG8_STAGE(PG8_SA(1, 1), a1 + hstep, voffA);
            PG8_WAIT_L(8); PG8_BAR; PG8_WAIT_L(0); PG8_MMA(0, 0, At, B0); PG8_BAR; PG8_SCHED;
            PG8_LDB(B1, 0, 1); PG8_STAGE(PG8_SB(0, 0), b2, voffB);
            PG8_BAR; PG8_WAIT_L(0); PG8_MMA(0, 1, At, B1); PG8_BAR;
            PG8_LDA(At, 0, 1); PG8_STAGE(PG8_SA(0, 0), a2, voffA);
            PG8_BAR; PG8_WAIT_L(0); PG8_MMA(1, 0, At, B0); PG8_BAR; PG8_SCHED;
            PG8_STAGE(PG8_SB(0, 1), b2 + hstep, voffB);
            PG8_WAIT_V(6); PG8_BAR; PG8_MMA(1, 1, At, B1); PG8_BAR;
            PG8_LDB(B0, 1, 0); PG8_SCHED; PG8_LDA(At, 1, 0); PG8_STAGE(PG8_SA(0, 1), a2 + hstep, voffA);
            PG8_WAIT_L(8); PG8_BAR; PG8_WAIT_L(0); PG8_MMA(0, 0, At, B0); PG8_BAR; PG8_SCHED;
            PG8_LDB(B1, 1, 1); PG8_STAGE(PG8_SB(1, 0), b3, voffB);
            PG8_BAR; PG8_WAIT_L(0); PG8_MMA(0, 1, At, B1); PG8_BAR;
            PG8_LDA(At, 1, 1); PG8_STAGE(PG8_SA(1, 0), a3, voffA);
            PG8_BAR; PG8_WAIT_L(0); PG8_MMA(1, 0, At, B0); PG8_BAR; PG8_SCHED;
            PG8_STAGE(PG8_SB(1, 1), b3 + hstep, voffB);
            PG8_WAIT_V(6); PG8_BAR; PG8_MMA(1, 1, At, B1); PG8_BAR;
        }
        E(acc, cur, wr, wc, fr, fq);
        if (!has_next) break;
#pragma unroll
        for (int a = 0; a < 2; ++a)
#pragma unroll
            for (int b = 0; b < 2; ++b)
#pragma unroll
                for (int m = 0; m < 4; ++m)
#pragma unroll
                    for (int n = 0; n < 2; ++n) acc[a][b][m][n] = (f32x4){0.f, 0.f, 0.f, 0.f};
        cur = nxt; cA = nA; cB = nB; ++ui;
    }
    PG8_WAIT_V(0);
    if (wr == 0) PG8_BAR;
    PG8_BAR;
#undef PG8_SA
#undef PG8_SB
#undef PG8_STAGE
#undef PG8_LDA
#undef PG8_LDB
#undef PG8_MMA
#undef PG8_WAIT_V
#undef PG8_WAIT_L
#undef PG8_BAR
#undef PG8_SCHED
}
}

struct EpiT {
    int mode;
    int g, l;
    const float* rs; float* rs_out;
    int first;
    int wxb;
    __device__ __forceinline__ bool perm() const { return mode != 4; }
    __device__ __forceinline__ void res(const f32x4 (&acc)[2][2][4][2], const pg8::Unit& u, int wr, int wc, int fr, int fq) const {
        float* out = OUTP(); bf16_t* xb = (bf16_t*)(WSP() + WS_XB);
        const int row0 = u.pm * 256 + wr * 64 + fr, col0 = u.pn * 256 + wc * 32 + 4 * fq;
#pragma unroll
        for (int ai = 0; ai < 2; ++ai) {
            f32x4 xin[4][2][2];
#pragma unroll
            for (int m = 0; m < 4; ++m) {
                const int r = row0 + ai * 128 + m * 16;
                const bool ok = row_valid(g, r);
                const int rq = ok ? r : 0;
                const float* yp = (first ? (rq < 32768 ? INP(0) + ((size_t)g * 32768 + rq) * 1024 : INP(1) + (size_t)(rq - 32768) * 1024) : (const float*)yrow(out, g, rq)) + col0;
#pragma unroll
                for (int bj = 0; bj < 2; ++bj)
#pragma unroll
                    for (int n = 0; n < 2; ++n) xin[m][bj][n] = ok ? *(const f32x4*)(yp + bj * 128 + n * 16) : (f32x4){0.f, 0.f, 0.f, 0.f};
            }
#pragma unroll
            for (int m = 0; m < 4; ++m) {
                const int r = row0 + ai * 128 + m * 16;
                const bool ok = row_valid(g, r);
                float* yp = yrow(out, g, ok ? r : 0) + col0;
                bf16_t* xp = xb + (size_t)r * 1024 + col0;
                float ss = 0.f;
#pragma unroll
                for (int bj = 0; bj < 2; ++bj)
#pragma unroll
                    for (int n = 0; n < 2; ++n) {
                        const f32x4 x = xin[m][bj][n] + acc[ai][bj][m][n];
                        if (ok) {
                            *(f32x4*)(yp + bj * 128 + n * 16) = x;
                            if (wxb) { u32x2 w; w.x = cvt_pk_bf16(x[0], x[1]); w.y = cvt_pk_bf16(x[2], x[3]); *(u32x2*)(xp + bj * 128 + n * 16) = w; }
                            ss += (x[0] * x[0] + x[1] * x[1]) + (x[2] * x[2] + x[3] * x[3]);
                        }
                    }
                ss += __shfl_xor(ss, 16); ss += __shfl_xor(ss, 32);
                if (ok && fq == 0) atomicAdd(rs_out + r, ss);
            }
        }
    }
    __device__ __forceinline__ void epi_proj(const f32x4 (&acc)[2][2][4][2], const pg8::Unit& u, int wr, int wc, int fr, int fq) const {
        bf16_t* act = (bf16_t*)(WSP() + WS_ACT); bf16_t* H = act; bf16_t* halo = (bf16_t*)(WSP() + WS_HALO); float* bg = (float*)(WSP() + WS_BG); float* out = OUTP();
        const float* a_log = INP(11); const float* dt_bias = INP(12);
        const int row0 = u.pm * 256 + wr * 64 + fr;
        const int colt = u.pn * 256 + wc * 32 + 8 * fq;
        float rstd8[2][4];
#pragma unroll
        for (int ai = 0; ai < 2; ++ai)
#pragma unroll
            for (int m = 0; m < 4; ++m) rstd8[ai][m] = rs[row0 + ai * 128 + m * 16];
#pragma unroll
        for (int ai = 0; ai < 2; ++ai)
#pragma unroll
            for (int m = 0; m < 4; ++m) rstd8[ai][m] = rsqrtf(rstd8[ai][m] * (1.0f / 1024.0f) + EPS);
#pragma unroll
        for (int ai = 0; ai < 2; ++ai)
#pragma unroll
            for (int m = 0; m < 4; ++m) {
                const int r = row0 + ai * 128 + m * 16;
                    const float rstd = rstd8[ai][m];
                    if (u.pn == 32) {
                        if (wc == 0 && fq < 2) {
                            const f32x4 v0 = acc[ai][0][m][0] * rstd, v1 = acc[ai][0][m][1] * rstd;
                            float o8[8] = {v0[0], v0[1], v0[2], v0[3], v1[0], v1[1], v1[2], v1[3]};
#pragma unroll
                            for (int h = 0; h < 8; ++h) {
                                if (fq == 0) o8[h] = sigmoidf_(o8[h]);
                                else { const float xx = o8[h] + dt_bias[l * 8 + h]; const float sp = xx > 20.f ? xx : log1pf(__expf(xx)); o8[h] = -__expf(a_log[l * 8 + h]) * sp; }
                            }
                            float* dst = bg + (size_t)r * 16 + 8 * fq;
                            *(f32x4*)dst = (f32x4){o8[0], o8[1], o8[2], o8[3]}; *(f32x4*)(dst + 4) = (f32x4){o8[4], o8[5], o8[6], o8[7]};
                        }
                    } else {
                        const int slot = u.pn >> 2;
                        bf16_t* rowp = act + (size_t)slot * SLOT_EL + (size_t)r * 1024 + (colt & 1023);
#pragma unroll
                        for (int bj = 0; bj < 2; ++bj) {
                            f32x4 v0 = acc[ai][bj][m][0] * rstd, v1 = acc[ai][bj][m][1] * rstd;
                            if (slot < 2) {
                                f32x2 a = gelu_pk((f32x2){v0[0], v0[1]}), b = gelu_pk((f32x2){v0[2], v0[3]}), c = gelu_pk((f32x2){v1[0], v1[1]}), d = gelu_pk((f32x2){v1[2], v1[3]});
                                v0 = (f32x4){a.x, a.y, b.x, b.y}; v1 = (f32x4){c.x, c.y, d.x, d.y};
                            } else if (slot == 5) {
#pragma unroll
                                for (int j = 0; j < 4; ++j) { v0[j] = siluf_(v0[j]); v1[j] = siluf_(v1[j]); }
                            } else if (slot >= 6) {
#pragma unroll
                                for (int j = 0; j < 4; ++j) { v0[j] = sigmoidf_(v0[j]); v1[j] = sigmoidf_(v1[j]); }
                            }
                            u32x4 w; w.x = cvt_pk_bf16(v0[0], v0[1]); w.y = cvt_pk_bf16(v0[2], v0[3]); w.z = cvt_pk_bf16(v1[0], v1[1]); w.w = cvt_pk_bf16(v1[2], v1[3]);
                            *(u32x4*)(rowp + bj * 128) = w;
                            if (slot >= 2 && slot <= 4) {
                                const int ch = (slot - 2) * 1024 + (colt & 1023) + bj * 128;
                                if ((r & 63) >= 61) *(u32x4*)(halo + ((size_t)(r >> 6) * 3 + ((r & 63) - 61)) * 3072 + ch) = w;
                                float* cdst = nullptr;
                                if (r < 32768) { if ((r & 4095) >= 4093) cdst = out + OCP + (((size_t)l * 16 + g * 8 + (r >> 12)) * 3 + ((r & 4095) - 4093)) * 3072 + ch; }
                                else if (g == 0 && r < 32896) { const int rr = r - 32768; if ((rr & 15) >= 13) cdst = out + OCS + (((size_t)l * 8 + (rr >> 4)) * 3 + ((rr & 15) - 13)) * 3072 + ch; }
                                if (cdst) { *(f32x4*)cdst = v0; *(f32x4*)(cdst + 4) = v1; }
                            }
                        }
                    }
            }
    }
    __device__ __forceinline__ void epi_up(const f32x4 (&acc)[2][2][4][2], const pg8::Unit& u, int wr, int wc, int fr, int fq) const {
        bf16_t* act = (bf16_t*)(WSP() + WS_ACT); bf16_t* H = act; bf16_t* halo = (bf16_t*)(WSP() + WS_HALO); float* bg = (float*)(WSP() + WS_BG); float* out = OUTP();
        const float* a_log = INP(11); const float* dt_bias = INP(12);
        const int row0 = u.pm * 256 + wr * 64 + fr;
        const int colt = u.pn * 256 + wc * 32 + 8 * fq;
        float rstd8[2][4];
#pragma unroll
        for (int ai = 0; ai < 2; ++ai)
#pragma unroll
            for (int m = 0; m < 4; ++m) rstd8[ai][m] = rs[row0 + ai * 128 + m * 16];
#pragma unroll
        for (int ai = 0; ai < 2; ++ai)
#pragma unroll
            for (int m = 0; m < 4; ++m) rstd8[ai][m] = rsqrtf(rstd8[ai][m] * (1.0f / 1024.0f) + EPS);
#pragma unroll
        for (int ai = 0; ai < 2; ++ai)
#pragma unroll
            for (int m = 0; m < 4; ++m) {
                const int r = row0 + ai * 128 + m * 16;
                    const float rstd = rstd8[ai][m];
                    bf16_t* rowp = H + (size_t)r * 4096 + colt;
#pragma unroll
                    for (int bj = 0; bj < 2; ++bj) {
                        f32x4 v0 = acc[ai][bj][m][0] * rstd, v1 = acc[ai][bj][m][1] * rstd;
#pragma unroll
                        for (int j = 0; j < 4; ++j) { v0[j] = fmaxf(v0[j], 0.f); v0[j] *= v0[j]; v1[j] = fmaxf(v1[j], 0.f); v1[j] *= v1[j]; }
                        u32x4 w; w.x = cvt_pk_bf16(v0[0], v0[1]); w.y = cvt_pk_bf16(v0[2], v0[3]); w.z = cvt_pk_bf16(v1[0], v1[1]); w.w = cvt_pk_bf16(v1[2], v1[3]);
                        *(u32x4*)(rowp + bj * 128) = w;
                    }
            }
    }
    __device__ __forceinline__ void epi_gate(const f32x4 (&acc)[2][2][4][2], const pg8::Unit& u, int wr, int wc, int fr, int fq) const {
        bf16_t* act = (bf16_t*)(WSP() + WS_ACT);
        const int row0 = u.pm * 256 + wr * 64 + fr;
        const int colt = u.pn * 256 + wc * 32 + 8 * fq;
#pragma unroll
        for (int ai = 0; ai < 2; ++ai) {
            u32x4 gw[4][2], tw[4][2];
#pragma unroll
            for (int m = 0; m < 4; ++m) {
                const int r = row0 + ai * 128 + m * 16;
                const bf16_t* ga = act + (size_t)6 * SLOT_EL + (size_t)r * 1024 + colt;
                const bf16_t* gb = act + (size_t)7 * SLOT_EL + (size_t)r * 1024 + colt;
#pragma unroll
                for (int bj = 0; bj < 2; ++bj) { gw[m][bj] = *(const u32x4*)((mode == 1 ? ga : gb) + bj * 128); tw[m][bj] = mode == 2 ? *(const u32x4*)(ga + bj * 128) : (u32x4){0u, 0u, 0u, 0u}; }
            }
#pragma unroll
            for (int m = 0; m < 4; ++m) {
                const int r = row0 + ai * 128 + m * 16;
                bf16_t* dst = act + (size_t)(mode == 1 ? 6 : 7) * SLOT_EL + (size_t)r * 1024 + colt;
#pragma unroll
                for (int bj = 0; bj < 2; ++bj) {
                    const f32x4 a0 = acc[ai][bj][m][0], a1 = acc[ai][bj][m][1];
                    const u32x4 g4 = gw[m][bj], t4 = tw[m][bj];
                    float o[8] = {a0[0] * bflo(g4.x), a0[1] * bfhi(g4.x), a0[2] * bflo(g4.y), a0[3] * bfhi(g4.y), a1[0] * bflo(g4.z), a1[1] * bfhi(g4.z), a1[2] * bflo(g4.w), a1[3] * bfhi(g4.w)};
                    o[0] += bflo(t4.x); o[1] += bfhi(t4.x); o[2] += bflo(t4.y); o[3] += bfhi(t4.y); o[4] += bflo(t4.z); o[5] += bfhi(t4.z); o[6] += bflo(t4.w); o[7] += bfhi(t4.w);
                    u32x4 w; w.x = cvt_pk_bf16(o[0], o[1]); w.y = cvt_pk_bf16(o[2], o[3]); w.z = cvt_pk_bf16(o[4], o[5]); w.w = cvt_pk_bf16(o[6], o[7]);
                    *(u32x4*)(dst + bj * 128) = w;
                }
            }
        }
    }
    __device__ __forceinline__ void operator()(const f32x4 (&acc)[2][2][4][2], const pg8::Unit& u, int wr, int wc, int fr, int fq) const {
        if (mode == 4) res(acc, u, wr, wc, fr, fq);
        else if (mode == 0) epi_proj(acc, u, wr, wc, fr, fq);
        else if (mode == 3) epi_up(acc, u, wr, wc, fr, fq);
        else epi_gate(acc, u, wr, wc, fr, fq);
    }
};

__device__ __forceinline__ void win_map(int nd, int& ns, int& nv) {
    if (nd < 6144) { ns = nd; nv = 64; } else if (nd < 8192) { ns = nd + 16; nv = 64; } else if (nd == 8192) { ns = 6144; nv = 16; } else { ns = 0; nv = 0; }
}
__device__ __forceinline__ void wconv_strip(const float* W, int ldw, int k0, int nd0, bool winmap, const float* kscale, bf16_t* Bt, int K, unsigned char* lds, const int tidx) {
    bf16_t* tile = (bf16_t*)lds;
    const int t = tidx;
    { const int k = t >> 3, n0 = (t & 7) * 8;
      f32x4 a[4], b[4];
#pragma unroll
      for (int q = 0; q < 4; ++q) {
          int ns = nd0 + 64 * q, nv = 64; if (winmap) win_map(nd0 + 64 * q, ns, nv);
          a[q] = (f32x4){0.f, 0.f, 0.f, 0.f}; b[q] = a[q];
          if (n0 < nv) { const float* src = W + (size_t)(k0 + k) * ldw + ns + n0; a[q] = *(const f32x4*)src; b[q] = *(const f32x4*)(src + 4); }
      }
      const float sc = kscale ? kscale[k0 + k] : 1.0f;
#pragma unroll
      for (int q = 0; q < 4; ++q) {
          float v[8] = {a[q][0], a[q][1], a[q][2], a[q][3], b[q][0], b[q][1], b[q][2], b[q][3]};
#pragma unroll
          for (int i = 0; i < 8; ++i) tile[(q * 64 + n0 + i) * 72 + k] = f2bf(v[i] * sc);
      }
    }
    __syncthreads();
    { const int n = t >> 3, kk = (t & 7) * 8;
#pragma unroll
      for (int q = 0; q < 4; ++q) *(u32x4*)(Bt + (size_t)(nd0 + 64 * q + n) * K + k0 + kk) = *(const u32x4*)(tile + (q * 64 + n) * 72 + kk); }
    __syncthreads();
}
__device__ __forceinline__ void phase_wconv(const Params& p, unsigned char* lds, const int tidx) {
    bf16_t* WT = (bf16_t*)(WSP() + WS_W);
    for (int j = blockIdx.x; j < 2 * 1232; j += gridDim.x) {
        const int l = j / 1232; int jj = j % 1232;
        bf16_t* wl = WT + (size_t)l * W_LAYER;
        if (jj < 528) {
            const int st = jj >> 4, kt = jj & 15;
            wconv_strip(INP(5) + (size_t)l * 1024 * NIN, NIN, kt * 64, st * 256, true, INP(4) + l * 1024, wl + W_IN, 1024, lds, tidx);
        } else if (jj < 528 + 192) {
            jj -= 528; const int which = jj >> 6; jj &= 63; const int st = jj >> 4, kt = jj & 15;
            const float* src = INP(14 + which) + (size_t)l * 1048576;
            wconv_strip(src, 1024, kt * 64, st * 256, false, nullptr, wl + (which == 0 ? W_PA : which == 1 ? W_PB : W_WO), 1024, lds, tidx);
        } else if (jj < 528 + 192 + 256) {
            jj -= 720; const int st = jj >> 4, kt = jj & 15;
            wconv_strip(INP(18) + (size_t)l * 4194304, 4096, kt * 64, st * 256, false, INP(17) + l * 1024, wl + W_UP, 1024, lds, tidx);
        } else {
            jj -= 976; const int st = jj >> 6, kt = jj & 63;
            wconv_strip(INP(19) + (size_t)l * 4194304, 1024, kt * 64, st * 256, false, nullptr, wl + W_DN, 4096, lds, tidx);
        }
    }
    float* rs = (float*)(WSP() + WS_RS);
    for (int i = blockIdx.x * NTHREADS + tidx; i < 10 * TGMAX; i += gridDim.x * NTHREADS) if ((i / TGMAX) % 5 != 0) rs[i] = 0.f;
}

__device__ __forceinline__ void phase_s0(const Params& p, int g, int Tg, const int tidx) {
    bf16_t* XB = (bf16_t*)(WSP() + WS_XB); float* rs = (float*)(WSP() + WS_RS) + (size_t)(g * 5) * TGMAX;
    const int lane = tidx & 63, wv = blockIdx.x * 8 + (tidx >> 6);
    for (int r = wv; r < Tg; r += gridDim.x * 8) {
        const bool ok = row_valid(g, r);
        float ss = 0.f;
        if (ok) {
            const float* src = r < 32768 ? INP(0) + ((size_t)g * 32768 + r) * 1024 : INP(1) + (size_t)(r - 32768) * 1024;
#pragma unroll
            for (int i = 0; i < 4; ++i) {
                const f32x4 x = *(const f32x4*)(src + 4 * lane + 256 * i);
                u32x2 w; w.x = cvt_pk_bf16(x[0], x[1]); w.y = cvt_pk_bf16(x[2], x[3]);
                *(u32x2*)(XB + (size_t)r * 1024 + 4 * lane + 256 * i) = w;
                ss += (x[0] * x[0] + x[1] * x[1]) + (x[2] * x[2] + x[3] * x[3]);
            }
        } else {
#pragma unroll
            for (int i = 0; i < 4; ++i) *(u32x2*)(XB + (size_t)r * 1024 + 4 * lane + 256 * i) = (u32x2){0u, 0u};
        }
        ss = wave_sum(ss);
        if (lane == 0) rs[r] = ss;
    }
}
__device__ __forceinline__ void phase_final(const Params& p, int g, int Tg, const int tidx) {
    const float* rs = (const float*)(WSP() + WS_RS) + (size_t)(g * 5 + 4) * TGMAX; const float* fn = INP(20);
    const int lane = tidx & 63, wv = blockIdx.x * 8 + (tidx >> 6);
    for (int r = wv; r < Tg; r += gridDim.x * 8) {
        if (!row_valid(g, r)) continue;
        const float rstd = rsqrtf(rs[r] * (1.0f / 1024.0f) + EPS);
        float* dst = yrow(OUTP(), g, r);
#pragma unroll
        for (int i = 0; i < 4; ++i) { const int c = 4 * lane + 256 * i; f32x4 x = *(const f32x4*)(dst + c); const f32x4 w = *(const f32x4*)(fn + c); *(f32x4*)(dst + c) = x * rstd * w; }
    }
}

__device__ __forceinline__ f32x4 mma(bf16x8 x, bf16x8 y, f32x4 c) { return __builtin_amdgcn_mfma_f32_16x16x32_bf16(x, y, c, 0, 0, 0); }

__device__ __forceinline__ void gmlp_unit(const Params& p, int g, int l, int ci, unsigned char* lds, const int tidx) {
    bf16_t* U = (bf16_t*)(WSP() + WS_ACT); const bf16_t* VA = U + SLOT_EL;
    bf16_t* sVT = (bf16_t*)lds;
    bf16_t* sWs = (bf16_t*)(lds + 34816);
    f32x2* sStat = (f32x2*)(lds + 69632);
    const int tid = tidx, wid = __builtin_amdgcn_readfirstlane(tid >> 6), lane = tid & 63, fr = lane & 15, fq = lane >> 4;
    const bool smp = ci >= 256; const int sb = ci - 256;
    const int row0 = smp ? 32768 + 16 * sb : 128 * ci, nvalid = smp ? 16 : 128;
    const float* lng = INP(6) + l * 1024; const float* lnb = INP(7) + l * 1024;
    for (int i4 = 0; i4 < 16; i4 += 4) {
        u32x4 ra[4], rb[4];
#pragma unroll
        for (int k = 0; k < 4; ++k) {
            const int rr = wid * 16 + i4 + k; const int rc = rr < nvalid ? rr : 0;
            const bf16_t* src = VA + (size_t)(row0 + rc) * 1024;
            ra[k] = *(const u32x4*)(src + 8 * lane); rb[k] = *(const u32x4*)(src + 512 + 8 * lane);
        }
#pragma unroll
        for (int k = 0; k < 4; ++k) {
            const int rr = wid * 16 + i4 + k;
            const u32x4 a = ra[k], b = rb[k];
            float v[16] = {bflo(a.x), bfhi(a.x), bflo(a.y), bfhi(a.y), bflo(a.z), bfhi(a.z), bflo(a.w), bfhi(a.w), bflo(b.x), bfhi(b.x), bflo(b.y), bfhi(b.y), bflo(b.z), bfhi(b.z), bflo(b.w), bfhi(b.w)};
            float s = 0.f;
#pragma unroll
            for (int q = 0; q < 16; ++q) s += v[q];
            const float mean = wave_sum(s) * (1.0f / 1024.0f);
            float q2 = 0.f;
#pragma unroll
            for (int q = 0; q < 16; ++q) { const float d = v[q] - mean; q2 += d * d; }
            const float rstd = rsqrtf(wave_sum(q2) * (1.0f / 1024.0f) + EPS);
            if (lane == 0) sStat[rr] = rr < nvalid ? (f32x2){mean, rstd} : (f32x2){0.f, 0.f};
            if (smp && rr < nvalid) {
                float* dst = OUTP() + OGV + (((size_t)l * 8 + sb) * 16 + rr) * 1024;
#pragma unroll
                for (int hh = 0; hh < 2; ++hh) { const int c = 512 * hh + 8 * lane;
                    const f32x4 g0 = *(const f32x4*)(lng + c), g1 = *(const f32x4*)(lng + c + 4), b0 = *(const f32x4*)(lnb + c), b1 = *(const f32x4*)(lnb + c + 4);
                    f32x4 o0, o1;
#pragma unroll
                    for (int q = 0; q < 4; ++q) { o0[q] = (v[8 * hh + q] - mean) * rstd * g0[q] + b0[q]; o1[q] = (v[8 * hh + 4 + q] - mean) * rstd * g1[q] + b1[q]; }
                    *(f32x4*)(dst + c) = o0; *(f32x4*)(dst + c + 4) = o1; }
            }
        }
    }
    __syncthreads();
    for (int grp = 0; grp < 8; ++grp) {
        { const float* ws = INP(8) + ((size_t)l * 8 + grp) * 16384; const int t = tid >> 2, s0 = 32 * (tid & 3);
#pragma unroll
          for (int k = 0; k < 4; ++k) {
              f32x4 a = (f32x4){0.f, 0.f, 0.f, 0.f}, b = a;
              if (t < nvalid && s0 + 8 * k <= t) { a = *(const f32x4*)(ws + t * 128 + s0 + 8 * k); b = *(const f32x4*)(ws + t * 128 + s0 + 8 * k + 4); }
              float v[8] = {a[0], a[1], a[2], a[3], b[0], b[1], b[2], b[3]};
#pragma unroll
              for (int i = 0; i < 8; ++i) if (s0 + 8 * k + i > t) v[i] = 0.f;
              u32x4 w; w.x = cvt_pk_bf16(v[0], v[1]); w.y = cvt_pk_bf16(v[2], v[3]); w.z = cvt_pk_bf16(v[4], v[5]); w.w = cvt_pk_bf16(v[6], v[7]);
              *(u32x4*)(sWs + t * 136 + s0 + 8 * k) = w;
          } }
        { const int s = tid & 127, oct = tid >> 7; const f32x2 st = sStat[s];
#pragma unroll
          for (int ps = 0; ps < 4; ++ps) {
              const int c0 = 8 * (oct + 4 * ps), cg = grp * 128 + c0;
              float v[8] = {0.f, 0.f, 0.f, 0.f, 0.f, 0.f, 0.f, 0.f};
              if (s < nvalid) {
                  const u32x4 a = *(const u32x4*)(VA + (size_t)(row0 + s) * 1024 + cg);
                  const f32x4 g0 = *(const f32x4*)(lng + cg), g1 = *(const f32x4*)(lng + cg + 4), b0 = *(const f32x4*)(lnb + cg), b1 = *(const f32x4*)(lnb + cg + 4);
                  v[0] = (bflo(a.x) - st.x) * st.y * g0[0] + b0[0]; v[1] = (bfhi(a.x) - st.x) * st.y * g0[1] + b0[1];
                  v[2] = (bflo(a.y) - st.x) * st.y * g0[2] + b0[2]; v[3] = (bfhi(a.y) - st.x) * st.y * g0[3] + b0[3];
                  v[4] = (bflo(a.z) - st.x) * st.y * g1[0] + b1[0]; v[5] = (bfhi(a.z) - st.x) * st.y * g1[1] + b1[1];
                  v[6] = (bflo(a.w) - st.x) * st.y * g1[2] + b1[2]; v[7] = (bfhi(a.w) - st.x) * st.y * g1[3] + b1[3];
              }
#pragma unroll
              for (int i = 0; i < 8; ++i) sVT[(c0 + i) * 136 + s] = f2bf(v[i]);
          } }
        __syncthreads();
        { const int tb = wid >> 1, t0 = 32 * tb, c0 = 64 * (wid & 1);
          f32x4 acc[2][4];
#pragma unroll
          for (int a = 0; a < 2; ++a)
#pragma unroll
              for (int b = 0; b < 4; ++b) acc[a][b] = (f32x4){0.f, 0.f, 0.f, 0.f};
          for (int kk = 0; kk <= tb; ++kk) {
              bf16x8 yf[2], xf[4];
#pragma unroll
              for (int a = 0; a < 2; ++a) yf[a] = *(const bf16x8*)(sWs + (t0 + 16 * a + fr) * 136 + 32 * kk + 8 * fq);
#pragma unroll
              for (int b = 0; b < 4; ++b) xf[b] = *(const bf16x8*)(sVT + (c0 + 16 * b + fr) * 136 + 32 * kk + 8 * fq);
#pragma unroll
              for (int a = 0; a < 2; ++a)
#pragma unroll
                  for (int b = 0; b < 4; ++b) acc[a][b] = mma(xf[b], yf[a], acc[a][b]);
          }
#pragma unroll
          for (int a = 0; a < 2; ++a) {
              const int t = t0 + 16 * a + fr;
              if (t < nvalid) {
                  const float bs = INP(9)[((size_t)l * 8 + grp) * 128 + t];
#pragma unroll
                  for (int b = 0; b < 4; ++b) {
                      bf16_t* up = U + (size_t)(row0 + t) * 1024 + grp * 128 + c0 + 16 * b + 4 * fq;
                      const u32x2 uw = *(const u32x2*)up;
                      u32x2 w; w.x = cvt_pk_bf16(bflo(uw.x) * (acc[a][b][0] + bs), bfhi(uw.x) * (acc[a][b][1] + bs)); w.y = cvt_pk_bf16(bflo(uw.y) * (acc[a][b][2] + bs), bfhi(uw.y) * (acc[a][b][3] + bs));
                      *(u32x2*)up = w;
                  }
              }
          } }
        __syncthreads();
    }
}


template <int I>
__device__ __forceinline__ void solve_rows(float (&x)[64], const f32x4* A4, const bf16_t* src, const float* sBeta, const float* sGam, int part, bf16_t* dst, int nvalid) {
    if constexpr (I < 64) {
        f32x4 a4[(I + 3) / 4 + 1];
#pragma unroll
        for (int q = 0; q < (I + 3) / 4; ++q) a4[q] = A4[I * 16 + q];
        float a = bf2f(src[I * 136]) * sBeta[I];
        if (part == 1) a *= __expf(sGam[I]);
#pragma unroll
        for (int j = 0; j < I; ++j) a -= a4[j >> 2][j & 3] * x[j];
        x[I] = a;
        if (I < nvalid) *dst = f2bf(a);
        dst += 1024;
        asm volatile("" : "+v"(dst) :: "memory");
        solve_rows<I + 1>(x, A4, src, sBeta, sGam, part, dst, nvalid);
    }
}

__device__ __forceinline__ void d1_unit(const Params& p, int g, int l, int unit0, int nd1, unsigned char* lds0, const int tidx) {
    const int half = __builtin_amdgcn_readfirstlane(tidx >> 8), tid = tidx & 255, wid = __builtin_amdgcn_readfirstlane((tidx >> 6) & 3), lane = tidx & 63, fr = lane & 15, fq = lane >> 4;
    const int unit_raw = unit0 + half * (int)gridDim.x;
    const bool active = unit_raw < nd1;
    const int unit = active ? unit_raw : unit0;
    unsigned char* lds = lds0 + half * 69632;
    bf16_t* ACT = (bf16_t*)(WSP() + WS_ACT);
    bf16_t* Qb = ACT + 2 * SLOT_EL; bf16_t* Kb = ACT + 3 * SLOT_EL; bf16_t* Vb = ACT + 4 * SLOT_EL;
    bf16_t* KGT = (bf16_t*)(WSP() + WS_KGT) + (size_t)unit * 8192;
    bf16_t* Pm = (bf16_t*)(WSP() + WS_P) + (size_t)unit * 4096;
    const bf16_t* HALO = (const bf16_t*)(WSP() + WS_HALO);
    const float* BG = (const float*)(WSP() + WS_BG); float* GL = (float*)(WSP() + WS_GL);
    bf16_t* sq = (bf16_t*)lds; bf16_t* sk = sq + 64 * 136; bf16_t* sv = sk + 64 * 136;
    float* Am = (float*)(lds + 52224);
    float* sGam = (float*)(lds + 68608); float* sBeta = sGam + 64;
    const int cid = unit >> 3, h = unit & 7;
    const bool smp = cid >= 512; const int sb = cid - 512;
    const int row0 = smp ? 32768 + 16 * sb : 64 * cid, nvalid = smp ? 16 : 64;
    const int nloc = smp ? 0 : (cid & 63);
    if (active) for (int pass = 0; pass < 2; ++pass) { const int c = (tid >> 3) + 32 * pass, sub = tid & 7, d0 = 16 * sub;
      const f32x4* sCW = (const f32x4*)(lds0 + 139264);
      u32x4 raw[3][4][2];
#pragma unroll
      for (int X = 0; X < 3; ++X) {
          const bf16_t* buf = X == 0 ? Qb : (X == 1 ? Kb : Vb);
          const int chx = X * 1024 + 128 * h + d0;
#pragma unroll
          for (int j = 0; j < 4; ++j) {
              const int rr = c - 3 + j;
              raw[X][j][0] = (u32x4){0u, 0u, 0u, 0u}; raw[X][j][1] = raw[X][j][0];
              if (c < nvalid) {
                  if (rr >= 0) { const bf16_t* src = buf + (size_t)(row0 + rr) * 1024 + 128 * h + d0; raw[X][j][0] = *(const u32x4*)src; raw[X][j][1] = *(const u32x4*)(src + 8); }
                  else if (smp) {
                      const float* src = INP(2) + (((size_t)l * 8 + sb) * 3 + (rr + 3)) * 3072 + chx;
                      const f32x4 f0 = *(const f32x4*)src, f1 = *(const f32x4*)(src + 4), f2 = *(const f32x4*)(src + 8), f3 = *(const f32x4*)(src + 12);
                      raw[X][j][0] = (u32x4){cvt_pk_bf16(f0[0], f0[1]), cvt_pk_bf16(f0[2], f0[3]), cvt_pk_bf16(f1[0], f1[1]), cvt_pk_bf16(f1[2], f1[3])};
                      raw[X][j][1] = (u32x4){cvt_pk_bf16(f2[0], f2[1]), cvt_pk_bf16(f2[2], f2[3]), cvt_pk_bf16(f3[0], f3[1]), cvt_pk_bf16(f3[2], f3[3])};
                  } else if (nloc > 0) { const bf16_t* src = HALO + ((size_t)(cid - 1) * 3 + (rr + 3)) * 3072 + chx; raw[X][j][0] = *(const u32x4*)src; raw[X][j][1] = *(const u32x4*)(src + 8); }
              }
          }
      }
#pragma unroll
      for (int X = 0; X < 3; ++X) {
          float y[16];
#pragma unroll
          for (int i = 0; i < 16; ++i) {
              const f32x4 w = sCW[X * 128 + d0 + i];
              float acc = 0.f;
#pragma unroll
              for (int j = 0; j < 4; ++j) { const unsigned wd = raw[X][j][i >> 3][(i >> 1) & 3]; acc += ((i & 1) ? bfhi(wd) : bflo(wd)) * w[j]; }
              y[i] = c < nvalid ? siluf_(acc) : 0.f;
          }
          if (X < 2) {
              float ss = 0.f;
#pragma unroll
              for (int i = 0; i < 16; ++i) ss += y[i] * y[i];
              ss += __shfl_xor(ss, 1); ss += __shfl_xor(ss, 2); ss += __shfl_xor(ss, 4);
              const float sc = rsqrtf(ss + EPS) * (X == 0 ? 0.08838834764831845f : 1.0f);
#pragma unroll
              for (int i = 0; i < 16; ++i) y[i] *= sc;
          }
          bf16_t* dst = (X == 0 ? sq : (X == 1 ? sk : sv)) + c * 136 + d0;
          u32x4 w0, w1;
          w0.x = cvt_pk_bf16(y[0], y[1]); w0.y = cvt_pk_bf16(y[2], y[3]); w0.z = cvt_pk_bf16(y[4], y[5]); w0.w = cvt_pk_bf16(y[6], y[7]);
          w1.x = cvt_pk_bf16(y[8], y[9]); w1.y = cvt_pk_bf16(y[10], y[11]); w1.z = cvt_pk_bf16(y[12], y[13]); w1.w = cvt_pk_bf16(y[14], y[15]);
          *(u32x4*)dst = w0; *(u32x4*)(dst + 8) = w1;
      } }
    if (active && wid == 0) {
        float b = 0.f, gg = 0.f;
        if (lane < nvalid) { b = BG[(size_t)(row0 + lane) * 16 + h]; gg = BG[(size_t)(row0 + lane) * 16 + 8 + h]; }
#pragma unroll
        for (int o = 1; o < 64; o <<= 1) { const float t = __shfl_up(gg, o); if (lane >= o) gg += t; }
        sGam[lane] = gg; sBeta[lane] = b;
        if (lane == 63) GL[unit] = __expf(gg);
    }
    __syncthreads();
    if (active) for (int jb = wid * 8; jb < wid * 8 + 8; ++jb) {
        const int mat = jb >> 4, ti = (jb >> 2) & 3, tj = jb & 3;
        f32x4 acc = (f32x4){0.f, 0.f, 0.f, 0.f};
        if (tj <= ti) {
            const bf16_t* Y = mat == 0 ? sk : sq;
#pragma unroll
            for (int kk = 0; kk < 4; ++kk) {
                const bf16x8 xf = *(const bf16x8*)(sk + (16 * tj + fr) * 136 + 32 * kk + 8 * fq);
                const bf16x8 yf = *(const bf16x8*)(Y + (16 * ti + fr) * 136 + 32 * kk + 8 * fq);
                acc = mma(xf, yf, acc);
            }
        }
        const int i = 16 * ti + fr, j0 = 16 * tj + 4 * fq;
        const float gi = sGam[i], bi = sBeta[i];
        float zf = 0.f; asm volatile("" : "+v"(zf));
        float o[4];
#pragma unroll
        for (int jj = 0; jj < 4; ++jj) {
            const int j = j0 + jj;
            const bool keep = mat == 0 ? (j < i) : (j <= i);
            o[jj] = keep ? acc[jj] * __expf(gi - sGam[j]) * (mat == 0 ? bi : 1.0f) : zf;
        }
        if (mat == 0) *(f32x4*)(Am + i * 64 + j0) = (f32x4){o[0], o[1], o[2], o[3]};
        else { u32x2 w; w.x = cvt_pk_bf16(o[0], o[1]); w.y = cvt_pk_bf16(o[2], o[3]); *(u32x2*)(Pm + i * 64 + j0) = w; }
    }
    __syncthreads();
    if (active) {
        {
        const int part = wid >> 1, cc = tid & 127;
        const bf16_t* src = part == 0 ? sv : sk;
        bf16_t* dstb = (part == 0 ? Vb : Kb) + (size_t)row0 * 1024 + 128 * h + cc;
        float x[64];
        int zl = 0; asm volatile("" : "+v"(zl));
        solve_rows<0>(x, (const f32x4*)Am + zl, src + cc, sBeta + zl, sGam + zl, part, dstb, nvalid);
        }
        const int tt = tid;
        { const int c = tt >> 2, d0 = 32 * (tt & 3); const float eg = __expf(sGam[c]);
          if (c < nvalid) {
#pragma unroll
              for (int k = 0; k < 4; ++k) {
                  const u32x4 a = *(const u32x4*)(sq + c * 136 + d0 + 8 * k);
                  u32x4 w; w.x = cvt_pk_bf16(bflo(a.x) * eg, bfhi(a.x) * eg); w.y = cvt_pk_bf16(bflo(a.y) * eg, bfhi(a.y) * eg); w.z = cvt_pk_bf16(bflo(a.z) * eg, bfhi(a.z) * eg); w.w = cvt_pk_bf16(bflo(a.w) * eg, bfhi(a.w) * eg);
                  *(u32x4*)(Qb + (size_t)(row0 + c) * 1024 + 128 * h + d0 + 8 * k) = w;
              }
          } }
        { const int d = tt >> 1, c0 = 32 * (tt & 1); const float gl = sGam[63];
#pragma unroll
          for (int k = 0; k < 4; ++k) {
              float v[8];
#pragma unroll
              for (int i = 0; i < 8; ++i) { const int c = c0 + 8 * k + i; v[i] = bf2f(sk[c * 136 + d]) * __expf(gl - sGam[c]); }
              u32x4 w; w.x = cvt_pk_bf16(v[0], v[1]); w.y = cvt_pk_bf16(v[2], v[3]); w.z = cvt_pk_bf16(v[4], v[5]); w.w = cvt_pk_bf16(v[6], v[7]);
              *(u32x4*)(KGT + d * 64 + c0 + 8 * k) = w;
          } }
    }
    __syncthreads();
}

__device__ __forceinline__ void scan_unit(const Params& p, int g, int l, int su, unsigned char* lds, const int tidx) {
    bf16_t* ACT = (bf16_t*)(WSP() + WS_ACT);
    const bf16_t* Qg = ACT + 2 * SLOT_EL; const bf16_t* Wb = ACT + 3 * SLOT_EL; const bf16_t* Ub = ACT + 4 * SLOT_EL;
    const bf16_t* KGT = (const bf16_t*)(WSP() + WS_KGT); const bf16_t* Pm = (const bf16_t*)(WSP() + WS_P);
    bf16_t* Ob = (bf16_t*)(WSP() + WS_O); const float* GL = (const float*)(WSP() + WS_GL);
    bf16_t* sW = (bf16_t*)lds;
    bf16_t* sQ = sW + 64 * 136;
    bf16_t* sK = sQ + 64 * 136;
    bf16_t* sP = sK + 2 * 128 * 72;
    bf16_t* sST = sP + 2 * 64 * 72;
    bf16_t* sVn = sST + 64 * 136;
    const int tid = tidx, wid = __builtin_amdgcn_readfirstlane(tid >> 6), lane = tid & 63, fr = lane & 15, fq = lane >> 4;
    const bool smp = su >= 128; const int s2 = smp ? su - 128 : su;
    const int pairi = (s2 & 7) * 8 + (s2 >> 4), seq = pairi >> 3, h = pairi & 7, eq = (s2 >> 3) & 1;
    const int nsteps = smp ? 1 : 64, nvalid = smp ? 16 : 64;
    const int rowb = smp ? 32768 + 16 * seq : 4096 * seq;
    const int cid0 = smp ? 512 + seq : 64 * seq;
    const int ct = wid >> 1, ep = wid & 1;
    f32x4 accS[4];
    if (smp) {
        const float* s0 = INP(3) + (((size_t)l * 8 + seq) * 8 + h) * 16384;
#pragma unroll
        for (int e4 = 0; e4 < 4; ++e4)
#pragma unroll
            for (int j = 0; j < 4; ++j) accS[e4][j] = s0[(size_t)(16 * wid + 4 * fq + j) * 128 + 64 * eq + 16 * e4 + fr];
    } else {
#pragma unroll
        for (int e4 = 0; e4 < 4; ++e4) accS[e4] = (f32x4){0.f, 0.f, 0.f, 0.f};
    }
    u32x4 rW[2][2], rQ[2][2]; unsigned short rU[2][2][4]; float rGl[2];
    bf16x8 fK[2][2], fP[2][2];
#define SCAN_BAR() do { asm volatile("s_waitcnt lgkmcnt(0)" ::: "memory"); __builtin_amdgcn_s_barrier(); asm volatile("" ::: "memory"); } while (0)
#define SCAN_LOAD(n, S) do { const int _row = rowb + 64 * (n); const size_t _un = (size_t)(cid0 + (n)) * 8 + h; \
        _Pragma("unroll") for (int _i = 0; _i < 2; ++_i) { const int _ch = tid + 512 * _i, _c0 = _ch >> 4, _c = _c0 < nvalid ? _c0 : 0, _o = (_ch & 15) * 8;   \
            rW[S][_i] = *(const u32x4*)(Wb + (size_t)(_row + _c) * 1024 + 128 * h + _o); rQ[S][_i] = *(const u32x4*)(Qg + (size_t)(_row + _c) * 1024 + 128 * h + _o); \
            } \
        rGl[S] = GL[_un]; \
        _Pragma("unroll") for (int _t = 0; _t < 2; ++_t) _Pragma("unroll") for (int _j = 0; _j < 4; ++_j) { const int _c0 = 16 * ct + 4 * fq + _j, _c = _c0 < nvalid ? _c0 : 0; \
            rU[S][_t][_j] = Ub[(size_t)(_row + _c) * 1024 + 128 * h + 64 * eq + 16 * (2 * ep + _t) + fr]; } } while (0)
#define SCAN_STORE(n, S) do { const bool _live = (n) < nsteps; _Pragma("unroll") for (int _i = 0; _i < 2; ++_i) { const int _ch = tid + 512 * _i; const bool _ok = _live && (_ch >> 4) < nvalid; const u32x4 _z = (u32x4){0u, 0u, 0u, 0u}; \
            *(u32x4*)(sW + (_ch >> 4) * 136 + (_ch & 15) * 8) = _ok ? rW[S][_i] : _z; *(u32x4*)(sQ + (_ch >> 4) * 136 + (_ch & 15) * 8) = _ok ? rQ[S][_i] : _z; \
            } \
        _Pragma("unroll") for (int _t = 0; _t < 2; ++_t) _Pragma("unroll") for (int _j = 0; _j < 4; ++_j) uc[_t][_j] = (_live && (16 * ct + 4 * fq + _j) < nvalid) ? bf2f(rU[S][_t][_j]) : 0.f; \
        gl = _live ? rGl[S] : 1.0f; } while (0)
#define SCAN_PUT_ST() do { _Pragma("unroll") for (int e4 = 0; e4 < 4; ++e4) { u32x2 w; w.x = cvt_pk_bf16(accS[e4][0], accS[e4][1]); w.y = cvt_pk_bf16(accS[e4][2], accS[e4][3]); \
        *(u32x2*)(sST + (16 * e4 + fr) * 136 + 16 * wid + 4 * fq) = w; } } while (0)
    float uc[2][4], gl;
    const int nlast = nsteps - 1;
#define SCAN_LOADF(n, PAR) do { const size_t _un = (size_t)(cid0 + (n)) * 8 + h; _Pragma("unroll") for (int _k = 0; _k < 2; ++_k) { \
        fK[PAR][_k] = *(const bf16x8*)(KGT + _un * 8192 + (size_t)(16 * wid + fr) * 64 + 32 * _k + 8 * fq); \
        fP[PAR][_k] = *(const bf16x8*)(Pm + _un * 4096 + (size_t)(16 * ct + fr) * 64 + 32 * _k + 8 * fq); } } while (0)
    SCAN_LOAD(0, 0);
    SCAN_LOAD((1 < nlast ? 1 : nlast), 1);
    SCAN_STORE(0, 0);
    SCAN_PUT_ST();
    SCAN_LOAD((2 < nlast ? 2 : nlast), 0);
    SCAN_LOADF(0, 0);
    SCAN_LOADF((1 < nlast ? 1 : nlast), 1);
    SCAN_BAR();
#define SCAN_STEP(n, S1) do { \
        f32x4 t1[2], oacc[2]; \
        t1[0] = (f32x4){0.f, 0.f, 0.f, 0.f}; t1[1] = t1[0]; oacc[0] = t1[0]; oacc[1] = t1[0]; \
        { bf16x8 wf[4], qf[4], sf[2][4]; \
          _Pragma("unroll") for (int kk = 0; kk < 4; ++kk) { wf[kk] = *(const bf16x8*)(sW + (16 * ct + fr) * 136 + 32 * kk + 8 * fq); \
              sf[0][kk] = *(const bf16x8*)(sST + (16 * (2 * ep) + fr) * 136 + 32 * kk + 8 * fq); sf[1][kk] = *(const bf16x8*)(sST + (16 * (2 * ep + 1) + fr) * 136 + 32 * kk + 8 * fq); } \
          _Pragma("unroll") for (int kk = 0; kk < 4; ++kk) qf[kk] = *(const bf16x8*)(sQ + (16 * ct + fr) * 136 + 32 * kk + 8 * fq); \
          _Pragma("unroll") for (int kk = 0; kk < 4; ++kk) { t1[0] = mma(wf[kk], sf[0][kk], t1[0]); t1[1] = mma(wf[kk], sf[1][kk], t1[1]); } \
          _Pragma("unroll") for (int kk = 0; kk < 4; ++kk) { oacc[0] = mma(sf[0][kk], qf[kk], oacc[0]); oacc[1] = mma(sf[1][kk], qf[kk], oacc[1]); } } \
        _Pragma("unroll") for (int _t = 0; _t < 2; ++_t) { u32x2 w; w.x = cvt_pk_bf16(uc[_t][0] - t1[_t][0], uc[_t][1] - t1[_t][1]); w.y = cvt_pk_bf16(uc[_t][2] - t1[_t][2], uc[_t][3] - t1[_t][3]); \
            *(u32x2*)(sVn + (16 * (2 * ep + _t) + fr) * 72 + 16 * ct + 4 * fq) = w; } \
        SCAN_BAR(); \
        const float glc = gl; \
        SCAN_STORE((n) + 1, S1); { const int _n3 = (n) + 3 < nlast ? (n) + 3 : nlast; SCAN_LOAD(_n3, S1); } \
        _Pragma("unroll") for (int kk = 0; kk < 2; ++kk) { \
            const bf16x8 pf = fP[1 - (S1)][kk]; \
            _Pragma("unroll") for (int _t = 0; _t < 2; ++_t) { const bf16x8 vf = *(const bf16x8*)(sVn + (16 * (2 * ep + _t) + fr) * 72 + 32 * kk + 8 * fq); oacc[_t] = mma(vf, pf, oacc[_t]); } } \
        if ((n) < nsteps && 16 * ct + fr < nvalid) { _Pragma("unroll") for (int _t = 0; _t < 2; ++_t) { u32x2 w; w.x = cvt_pk_bf16(oacc[_t][0], oacc[_t][1]); w.y = cvt_pk_bf16(oacc[_t][2], oacc[_t][3]); \
            *(u32x2*)(Ob + ((((size_t)(cid0 + (n)) * 8 + h) * 2 + eq) * 64 + 16 * ct + fr) * 64 + 16 * (2 * ep + _t) + 4 * fq) = w; } } \
        _Pragma("unroll") for (int e4 = 0; e4 < 4; ++e4) accS[e4] *= glc; \
        _Pragma("unroll") for (int kk = 0; kk < 2; ++kk) { \
            const bf16x8 kf = fK[1 - (S1)][kk]; \
            _Pragma("unroll") for (int e4 = 0; e4 < 4; ++e4) { \
                const bf16x8 vf = *(const bf16x8*)(sVn + (16 * e4 + fr) * 72 + 32 * kk + 8 * fq); \
                accS[e4] = mma(kf, vf, accS[e4]); } } \
        { const int _n2 = (n) + 2 < nlast ? (n) + 2 : nlast; SCAN_LOADF(_n2, 1 - (S1)); } \
        SCAN_PUT_ST(); \
        SCAN_BAR(); } while (0)
    for (int n = 0; n < nsteps; n += 2) {
        SCAN_STEP(n, 1);
        SCAN_STEP(n + 1, 0);
    }
    __syncthreads();
#undef SCAN_STEP
#undef SCAN_PUT_ST
#undef SCAN_BAR
#undef SCAN_LOAD
#undef SCAN_LOADF
#undef SCAN_STORE
    float* dS = smp ? OUTP() + ODS + (((size_t)l * 8 + seq) * 8 + h) * 16384 : OUTP() + ODP + (((size_t)l * 16 + g * 8 + seq) * 8 + h) * 16384;
#pragma unroll
    for (int e4 = 0; e4 < 4; ++e4)
#pragma unroll
        for (int j = 0; j < 4; ++j) dS[(size_t)(16 * wid + 4 * fq + j) * 128 + 64 * eq + 16 * e4 + fr] = accS[e4][j];
}

__device__ __forceinline__ void phase_zb(const Params& p, int g, int l, int Tg, const int tidx) {
    const bf16_t* Ob = (const bf16_t*)(WSP() + WS_O); bf16_t* ZB = (bf16_t*)(WSP() + WS_ZB); const bf16_t* Zs = (const bf16_t*)(WSP() + WS_ACT) + 5 * SLOT_EL; const float* on = INP(13) + l * 128;
    const int lane16 = tidx & 15;
    const long total = (long)Tg * 8, stride = (long)gridDim.x * 32;
    const f32x4 n0 = *(const f32x4*)(on + 8 * lane16), n1 = *(const f32x4*)(on + 8 * lane16 + 4);
    for (long it0 = (long)blockIdx.x * 32 + (tidx >> 4); it0 < total; it0 += 4 * stride) {
        u32x4 av[4], zv[4]; bool okv[4]; int rv[4], hv[4];
#pragma unroll
        for (int k = 0; k < 4; ++k) {
            const long it = it0 + k * stride; const bool in = it < total;
            const int r = in ? (int)(it >> 3) : 0, h = (int)(it & 7);
            rv[k] = in ? r : -1; hv[k] = h; okv[k] = in && row_valid(g, r);
            const int rq = okv[k] ? r : 0;
            int cid, c; if (rq < 32768) { cid = rq >> 6; c = rq & 63; } else { cid = 512 + ((rq - 32768) >> 4); c = (rq - 32768) & 15; }
            av[k] = *(const u32x4*)(Ob + ((((size_t)cid * 8 + h) * 2 + (lane16 >> 3)) * 64 + c) * 64 + 8 * (lane16 & 7));
            zv[k] = *(const u32x4*)(Zs + (size_t)rq * 1024 + 128 * h + 8 * lane16);
        }
#pragma unroll
        for (int k = 0; k < 4; ++k) {
            const u32x4 a = av[k], z = zv[k];
            float v[8] = {bflo(a.x), bfhi(a.x), bflo(a.y), bfhi(a.y), bflo(a.z), bfhi(a.z), bflo(a.w), bfhi(a.w)};
            float ss = 0.f;
#pragma unroll
            for (int i = 0; i < 8; ++i) ss += v[i] * v[i];
            ss += __shfl_xor(ss, 1); ss += __shfl_xor(ss, 2); ss += __shfl_xor(ss, 4); ss += __shfl_xor(ss, 8);
            const float rstd = okv[k] ? rsqrtf(ss * (1.0f / 128.0f) + EPS) : 0.f;
            u32x4 w;
            w.x = cvt_pk_bf16(v[0] * rstd * n0[0] * bflo(z.x), v[1] * rstd * n0[1] * bfhi(z.x)); w.y = cvt_pk_bf16(v[2] * rstd * n0[2] * bflo(z.y), v[3] * rstd * n0[3] * bfhi(z.y));
            w.z = cvt_pk_bf16(v[4] * rstd * n1[0] * bflo(z.z), v[5] * rstd * n1[1] * bfhi(z.z)); w.w = cvt_pk_bf16(v[6] * rstd * n1[2] * bflo(z.w), v[7] * rstd * n1[3] * bfhi(z.w));
            if (!okv[k]) w = (u32x4){0u, 0u, 0u, 0u};
            if (rv[k] >= 0) *(u32x4*)(ZB + (size_t)rv[k] * 1024 + 128 * hv[k] + 8 * lane16) = w;
        }
    }
}

#define XB_TMO      128
#define XB_XCNT(j)  (256  + 64 * (j))
#define XB_XSUB(j)  (1280 + 64 * (j))
#define XB_XGEN(j)  (2304 + 64 * (j))
#define XB_TOP      3328
#define XB_TOPGEN   3392
#define XCD_BAR_WORDS 3456
#define XB_SPIN_CAP (1u << 20)
__device__ __forceinline__ unsigned xb_ld(unsigned* p)              { return __hip_atomic_load(p, __ATOMIC_RELAXED, __HIP_MEMORY_SCOPE_AGENT); }
__device__ __forceinline__ unsigned xb_add(unsigned* p, unsigned v) { return __hip_atomic_fetch_add(p, v, __ATOMIC_RELAXED, __HIP_MEMORY_SCOPE_AGENT); }
__device__ __forceinline__ unsigned xb_xcc_id() { return (unsigned)__builtin_amdgcn_s_getreg((3 << 11) | 20) & 0xFu; }
#define XB_SPIN(cond, bar) do { unsigned _sp = 0; while (cond) { __builtin_amdgcn_s_sleep(1); \
    if ((++_sp & 255u) == 0u) { if (xb_ld(&(bar)[XB_TMO])) break; if (_sp > XB_SPIN_CAP) { atomicAdd(&(bar)[XB_TMO], 1u); break; } } } } while (0)
__device__ __forceinline__ void xcd_barrier_complete(unsigned* bar, unsigned x, unsigned& nloc, unsigned& nx) {
    const unsigned Gt = gridDim.x;
    unsigned sum, cnt, mine, sp = 0u;
    for (;;) {
        sum = 0u; cnt = 0u; mine = 0u;
#pragma unroll
        for (unsigned j = 0; j < 16; ++j) { const unsigned c = xb_ld(&bar[XB_XCNT(j)]); sum += c; cnt += (c > 0u) ? 1u : 0u; mine = (j == x) ? c : mine; }
        if (sum == Gt) break;
        __builtin_amdgcn_s_sleep(1);
        if ((++sp & 255u) == 0u) { if (xb_ld(&bar[XB_TMO])) break; if (sp > XB_SPIN_CAP) { atomicAdd(&bar[XB_TMO], 1u); break; } }
    }
    nloc = mine > 0u ? mine : 1u; nx = cnt > 0u ? cnt : 1u;
}
__device__ __forceinline__ void grid_barrier(unsigned* bar, unsigned x, volatile unsigned* st, int tidx) {
    asm volatile("s_waitcnt vmcnt(0)" ::: "memory");
    __syncthreads();
    if (tidx == 0) {
        __builtin_amdgcn_s_waitcnt(0);
        unsigned nloc = st[0], nx = st[1];
        if (nloc == 0u) { xcd_barrier_complete(bar, x, nloc, nx); st[0] = nloc; st[1] = nx; }
        const unsigned old = xb_add(&bar[XB_XSUB(x)], 1u);
        const unsigned gen = old / nloc;
        if (old + 1u == (gen + 1u) * nloc) {
            __builtin_amdgcn_fence(__ATOMIC_RELEASE, "agent");
            asm volatile("s_waitcnt vmcnt(0)" ::: "memory");
            const unsigned og = xb_add(&bar[XB_TOP], 1u);
            const unsigned tg = og / nx;
            if (og + 1u == (tg + 1u) * nx) xb_add(&bar[XB_TOPGEN], 1u);
            else XB_SPIN(xb_ld(&bar[XB_TOPGEN]) == tg, bar);
            __builtin_amdgcn_fence(__ATOMIC_ACQUIRE, "agent");
            xb_add(&bar[XB_XGEN(x)], 1u);
            asm volatile("s_waitcnt vmcnt(0)" ::: "memory");
        } else {
            XB_SPIN(xb_ld(&bar[XB_XGEN(x)]) == gen, bar);
            __builtin_amdgcn_fence(__ATOMIC_ACQUIRE, "agent");
            asm volatile("s_waitcnt vmcnt(0)" ::: "memory");
        }
    }
    __syncthreads();
}

__global__ void __launch_bounds__(NTHREADS, 2) fwd_megakernel(Params p) {
    extern __shared__ __attribute__((aligned(16))) unsigned char lds[];
    cg::grid_group grid = cg::this_grid();
    LAS unsigned char* ldsl = (LAS unsigned char*)lds;
    bf16_t* WT = (bf16_t*)(WSP() + WS_W);
    bf16_t* XB = (bf16_t*)(WSP() + WS_XB);
    bf16_t* ACT = (bf16_t*)(WSP() + WS_ACT);
    bf16_t* Ob = (bf16_t*)(WSP() + WS_O);
    float* RSall = (float*)(WSP() + WS_RS);
    const int G = gridDim.x, bid = blockIdx.x;

    volatile unsigned* bst = (volatile unsigned*)(lds + LDS_BYTES - 16);
    if (threadIdx.x < 2) bst[threadIdx.x] = 0u;
    const unsigned xcc = xb_xcc_id();
    if (threadIdx.x == 0) (void)xb_add(&((unsigned*)(WSP() + WS_BAR))[XB_XCNT(xcc)], 1u);
    __syncthreads();
    grid.sync();
#ifndef PH_END
#define PH_END 34
#endif
    unsigned nbar = 0; int rep = 0; (void)rep;
    for (int ph = 0; ph < PH_END; ++ph) {
        int tidx = threadIdx.x; asm volatile("" : "+v"(tidx));
        int kind, g = 0, l = 0;
        if (ph == 0) kind = 0;
        else if (ph <= 16) { g = 0; l = (ph - 1) >> 3; kind = 1 + ((ph - 1) & 7); }
        else if (ph <= 32) { g = 1; l = (ph - 17) >> 3; kind = 1 + ((ph - 17) & 7); }
        else kind = 10;
        const int Tg = g == 0 ? TGMAX : 32768;
        float* RS = RSall + (size_t)(g * 5) * TGMAX;
        const bf16_t* wl = WT + (size_t)l * W_LAYER;
        if (kind == 0) { phase_wconv(p, lds, tidx); phase_s0(p, 0, TGMAX, tidx); }
        else if (kind == 10) { phase_final(p, 1, 32768, tidx); }
        else if (kind == 2) {
            const int ngm = g == 0 ? 264 : 256, nd1 = g == 0 ? NUNITS : 4096;
            if (tidx < 384) { const int X = tidx >> 7, d = tidx & 127; ((f32x4*)(lds + 139264))[tidx] = *(const f32x4*)(INP(10) + ((size_t)l * 3072 + X * 1024 + 128 * (bid & 7) + d) * 4); }
            __syncthreads();
            for (int u = bid; u < 256; u += G) gmlp_unit(p, g, l, u, lds, tidx);
            if (G >= 72) { if (ngm > 256 && bid >= 64 && bid < 64 + (ngm - 256)) gmlp_unit(p, g, l, 256 + (bid - 64), lds, tidx); }
            else for (int u = 256 + bid; u < ngm; u += G) gmlp_unit(p, g, l, u, lds, tidx);
            for (int u = bid; u < nd1; u += 2 * G) d1_unit(p, g, l, u, nd1, lds, tidx);
        } else if (kind == 3) {
            if (G == 256) {
                if (bid >= 128) { pg8::Gemm gm{ACT, wl + W_PA, Tg, 1024, 1024}; pg8::StaticOrder S; S.init(Tg, 1024, 128, bid - 128); EpiT E{1, g, l, nullptr, nullptr, 0, 1}; pg8::gemm_phase<EpiT>(ldsl, gm, S, E, tidx); __syncthreads(); }
                if (bid < 128 || g == 0) scan_unit(p, g, l, bid, lds, tidx);
            } else {
                const int nsu = g == 0 ? 256 : 128;
                for (int u = bid; u < nsu; u += G) scan_unit(p, g, l, u, lds, tidx);
            }
        } else if (kind == 4 && G == 256) { phase_zb(p, g, l, Tg, tidx);
        } else {
            const bf16_t* A; const bf16_t* Bt; int N = 1024, K = 1024, mode; const float* rs = nullptr; float* rs_out = nullptr;
            if (kind == 1) { A = XB; Bt = wl + W_IN; N = NPROJ; mode = 0; rs = RS + (size_t)(2 * l) * TGMAX; }
            else if (kind == 4) { A = ACT; Bt = wl + W_PA; mode = 1; }
            else if (kind == 5) { A = (const bf16_t*)(WSP() + WS_ZB); Bt = wl + W_PB; mode = 2; }
            else if (kind == 6) { A = ACT + 7 * SLOT_EL; Bt = wl + W_WO; mode = 4; rs_out = RS + (size_t)(2 * l + 1) * TGMAX; }
            else if (kind == 7) { A = XB; Bt = wl + W_UP; N = DFF; mode = 3; rs = RS + (size_t)(2 * l + 1) * TGMAX; }
            else { A = ACT; Bt = wl + W_DN; K = DFF; mode = 4; rs_out = RS + (size_t)(2 * l + 2) * TGMAX; }
            pg8::Gemm gm{A, Bt, Tg, N, K}; pg8::StaticOrder S; S.init(Tg, N, G, bid);
            EpiT E{mode, g, l, rs, rs_out, (kind == 6 && l == 0) ? 1 : 0, (kind == 8 && l == 1) ? 0 : 1};
            pg8::gemm_phase<EpiT>(ldsl, gm, S, E, tidx);
            if (kind == 4) phase_zb(p, g, l, Tg, tidx);
            if (kind == 8 && g == 0 && l == 1) phase_s0(p, 1, 32768, tidx);
            if (kind == 1 && g == 1 && l == 0) phase_final(p, 0, TGMAX, tidx);
        }
        if (ph < PH_END - 1) { ++nbar; grid_barrier((unsigned*)(WSP() + WS_BAR), xcc, bst, tidx); }
#ifdef PROBE_BAR
        if (ph < PH_END - 1) { for (int xb = 0; xb < 2; ++xb) { ++nbar; grid_barrier((unsigned*)(WSP() + WS_BAR), xcc, bst, tidx); } }
#endif
#ifdef PROBE_KINDS
        if (rep == 0 && ((PROBE_KINDS >> kind) & 1)) { rep = 1; --ph; } else rep = 0;
#endif
    }
}

extern "C" void kernel_launch(void* const* d_in, const int* in_sizes, int n_in, void* d_out, int out_size, void* d_ws, size_t ws_size, hipStream_t stream) {
    static int grid_blocks = 0;
    if (!grid_blocks) {
        int dev = 0, cus = 0, per_cu = 0;
        hipGetDevice(&dev);
        hipDeviceGetAttribute(&cus, hipDeviceAttributeMultiprocessorCount, dev);
        if (hipFuncSetAttribute((const void*)fwd_megakernel, hipFuncAttributeMaxDynamicSharedMemorySize, LDS_BYTES) != hipSuccess) fprintf(stderr, "hipFuncSetAttribute failed\n");
        hipOccupancyMaxActiveBlocksPerMultiprocessor(&per_cu, (const void*)fwd_megakernel, NTHREADS, LDS_BYTES);
        if (per_cu < 1) per_cu = 1;
        grid_blocks = cus * 1;
        (void)hipGetLastError();
        if (ws_size < WS_END) fprintf(stderr, "workspace too small: %zu < %zu\n", ws_size, (size_t)WS_END);
    }
    Params p{};
    for (int i = 0; i < 21; ++i) p.in[i] = (const float*)d_in[i];
    p.out = (float*)d_out; p.ws = (unsigned char*)d_ws;
    (void)hipMemsetAsync((unsigned char*)d_ws + WS_BAR, 0, 16384, stream);
    void* args[] = {&p};
    hipError_t e = hipLaunchCooperativeKernel((void*)fwd_megakernel, dim3(grid_blocks), dim3(NTHREADS), args, LDS_BYTES, stream);
    if (e != hipSuccess) fprintf(stderr, "cooperative launch failed: %s (grid %d)\n", hipGetErrorString(e), grid_blocks);
}
```

```cpp
#include <hip/hip_runtime.h>
#include <hip/hip_cooperative_groups.h>
#include <cstdio>
namespace cg = cooperative_groups;

#define LAS __attribute__((address_space(3)))
typedef unsigned short bf16_t;
typedef short bf16x8 __attribute__((ext_vector_type(8)));
typedef float f32x4 __attribute__((ext_vector_type(4)));
typedef float f32x2 __attribute__((ext_vector_type(2)));
typedef unsigned u32x4 __attribute__((ext_vector_type(4)));
typedef unsigned u32x2 __attribute__((ext_vector_type(2)));

constexpr int DM = 1024, NIN = 8208, NPROJ = 8448, DFF = 4096;
constexpr int TGMAX = 33024;
constexpr int NTHREADS = 512;
constexpr float EPS = 1e-6f;
constexpr size_t SLOT_EL = (size_t)TGMAX * 1024;
constexpr size_t W_IN = 0, W_PA = W_IN + (size_t)NPROJ * 1024, W_PB = W_PA + 1048576, W_WO = W_PB + 1048576,
                 W_UP = W_WO + 1048576, W_DN = W_UP + 4194304, W_LAYER = W_DN + 4194304;
constexpr int NUNITS = 520 * 8;
constexpr size_t WS_W = 0;
constexpr size_t WS_XB = WS_W + 2 * W_LAYER * 2;
constexpr size_t WS_ACT = WS_XB + SLOT_EL * 2;
constexpr size_t WS_KGT = WS_ACT + 8 * SLOT_EL * 2;
constexpr size_t WS_O = WS_KGT + (size_t)NUNITS * 8192 * 2;
constexpr size_t WS_P = WS_O + (size_t)NUNITS * 8192 * 2;
constexpr size_t WS_HALO = WS_P + (size_t)NUNITS * 4096 * 2;
constexpr size_t WS_BG = WS_HALO + (size_t)516 * 3 * 3072 * 2;
constexpr size_t WS_GL = WS_BG + (size_t)TGMAX * 16 * 4;
constexpr size_t WS_RS = WS_GL + 32768;
constexpr size_t WS_ZB = WS_RS + (size_t)10 * TGMAX * 4;
constexpr size_t WS_BAR = WS_ZB + SLOT_EL * 2;
constexpr size_t WS_END = WS_BAR + 16384;
constexpr size_t OY_P = 0, OY_S = 67108864, OCP = 67239936, ODP = 67534848, OCS = 71729152, ODS = 71876608, OGV = 73973760;
constexpr int LDS_BYTES = 147456;

struct Params { const float* in[21]; float* out; unsigned char* ws; };


typedef const __attribute__((address_space(4))) char* kaptr_t;
__device__ __forceinline__ kaptr_t ka_base() { kaptr_t ka = (kaptr_t)__builtin_amdgcn_kernarg_segment_ptr(); asm volatile("" : "+s"(ka)); return ka; }
#define INP(i) (*(const float* const __attribute__((address_space(4)))*)(ka_base() + 8 * (i)))
#define OUTP() (*(float* const __attribute__((address_space(4)))*)(ka_base() + 8 * 21))
#define WSP() (*(unsigned char* const __attribute__((address_space(4)))*)(ka_base() + 8 * 22))

typedef __bf16 bf16v2_t __attribute__((ext_vector_type(2)));
__device__ __forceinline__ unsigned cvt_pk_bf16(float lo, float hi) { const f32x2 v = {lo, hi}; const bf16v2_t b = __builtin_convertvector(v, bf16v2_t); return __builtin_bit_cast(unsigned, b); }
__device__ __forceinline__ bf16_t f2bf(float f) { return (bf16_t)(cvt_pk_bf16(f, 0.f) & 0xffffu); }
__device__ __forceinline__ float bf2f(bf16_t b) { return __uint_as_float(((unsigned)b) << 16); }
__device__ __forceinline__ float bflo(unsigned w) { return __uint_as_float(w << 16); }
__device__ __forceinline__ float bfhi(unsigned w) { return __uint_as_float(w & 0xffff0000u); }
__device__ __forceinline__ float sigmoidf_(float x) { return __builtin_amdgcn_rcpf(1.0f + __builtin_amdgcn_exp2f(x * -1.44269504089f)); }
__device__ __forceinline__ float siluf_(float x) { return x * __builtin_amdgcn_rcpf(1.0f + __builtin_amdgcn_exp2f(x * -1.44269504089f)); }
__device__ __forceinline__ f32x2 gelu_pk(f32x2 v) {
    const f32x2 av = __builtin_elementwise_abs(v), d = av * 0.2316418882f + 1.0f;
    f32x2 t; t.x = __builtin_amdgcn_rcpf(d.x); t.y = __builtin_amdgcn_rcpf(d.y);
    f32x2 q = t * 0.5307027145f + (-0.7265760135f); q = q * t + 0.7107068705f; q = q * t + (-0.142248368f); q = q * t + 0.127414796f; q = q * t;
    const f32x2 s = (v * v) * (-0.72134752044f);
    f32x2 e; e.x = __builtin_amdgcn_exp2f(s.x); e.y = __builtin_amdgcn_exp2f(s.y);
    const f32x2 m = v * (q * e), r = v - m;
    f32x2 o; o.x = v.x < 0.f ? m.x : r.x; o.y = v.y < 0.f ? m.y : r.y; return o;
}
__device__ __forceinline__ float wave_sum(float v) {
#pragma unroll
    for (int o = 32; o >= 1; o >>= 1) v += __shfl_xor(v, o);
    return v;
}
__device__ __forceinline__ bool row_valid(int g, int r) { return r < 32768 || (g == 0 && r < 32896); }
__device__ __forceinline__ float* yrow(float* out, int g, int r) { return r < 32768 ? out + OY_P + ((size_t)g * 32768 + r) * 1024 : out + OY_S + (size_t)(r - 32768) * 1024; }

namespace pg8 {
constexpr int BM = 256, BK = 64, HALF = 128, HTB = HALF * BK * 2, STAGE_BYTES = 8 * HTB, NXCD = 8, WGM = 6;
__device__ __forceinline__ int lds_byte(int r, int c) { const int st = (r >> 4) * 2 + (c >> 5), rr = r & 15, cc = c & 31, ob = rr * 64 + cc * 2; return st * 1024 + (ob ^ (((ob >> 9) & 1) << 5)); }
__device__ __forceinline__ void stage_rc(int b, int& R, int& C) { const int st = b / 1024, sb = b % 1024, swz = sb ^ (((sb >> 9) & 1) << 5); R = (st >> 1) * 16 + swz / 64; C = (st & 1) * 32 + (swz % 64) / 2; }
__device__ __forceinline__ int perm32(int rho) { const int n = rho >> 4, i = rho & 15; return 8 * (i >> 2) + 4 * n + (i & 3); }
struct Unit { int pm, pn; };
struct Gemm { const bf16_t* A; const bf16_t* Bt; int M, N, K; };
struct StaticOrder {
    int nM, nN, nwg, G, c;
    __device__ void init(int M, int N, int G_, int c_) { nM = M / BM; nN = N / BM; nwg = nM * nN; G = G_; c = c_; }
    __device__ bool next(int i, Unit& u) const {
        const long L = (long)i * G + c; if (L >= nwg) return false;
        int wgid = (int)L; { const int q = nwg / NXCD, r = nwg % NXCD, xcd = wgid % NXCD, off = wgid / NXCD; wgid = (xcd < r ? xcd * (q + 1) : r * (q + 1) + (xcd - r) * q) + off; }
        const int nig = WGM * nN, gid = wgid / nig, fm = gid * WGM, gsz = (nM - fm) < WGM ? (nM - fm) : WGM;
        u.pm = fm + ((wgid % nig) % gsz); u.pn = (wgid % nig) / gsz; return true;
    }
};
template <class Epi>
__device__ __forceinline__ void gemm_phase(LAS unsigned char* lds, const Gemm g, const StaticOrder& S, const Epi& E, const int tidx) {
    const int tid = tidx, wid = __builtin_amdgcn_readfirstlane(tid >> 6), lane = tid & 63, wr = wid >> 2, wc = wid & 3, fr = lane & 15, fq = lane >> 4;
    const int K = g.K, nt = K / BK;
    unsigned voffA[2], voffB[2];
#pragma unroll
    for (int i = 0; i < 2; ++i) { int R, C; stage_rc(tid * 16 + i * 8192, R, C); const int Rb = E.perm() ? ((R & ~31) + perm32(R & 31)) : R;
        voffA[i] = (unsigned)(R * K + C) * 2u; voffB[i] = (unsigned)(Rb * K + C) * 2u; }
    const size_t kstep = (size_t)(BK * 2);
    const size_t hstep = (size_t)HALF * K * 2;
    const size_t tstep = 2 * hstep;
    const unsigned ldsw = (unsigned)wid * 1024u;
    const int aoff = lds_byte(wr * 64 + fr, fq * 8), boff = lds_byte(wc * 32 + fr, fq * 8);
#define PG8_SA(b, h) (((b) * 2 + (h)) * HTB)
#define PG8_SB(b, h) ((4 + (b) * 2 + (h)) * HTB)
#define PG8_STAGE(bufoff, gbase, voff) do { _Pragma("unroll") for (int _i = 0; _i < 2; ++_i) \
        __builtin_amdgcn_global_load_lds((const unsigned*)((const char*)(gbase) + (voff)[_i]), (LAS unsigned*)(lds + (bufoff) + ldsw + _i * 8192), 16, 0, 0); } while (0)
#define PG8_LDA(dst, b, h) do { _Pragma("unroll") for (int m = 0; m < 4; ++m) _Pragma("unroll") for (int k = 0; k < 2; ++k) dst[m][k] = *(const LAS bf16x8*)(lds + PG8_SA(b, h) + aoff + m * 2048 + k * 1024); } while (0)
#define PG8_LDB(dst, b, h) do { _Pragma("unroll") for (int n = 0; n < 2; ++n) _Pragma("unroll") for (int k = 0; k < 2; ++k) dst[n][k] = *(const LAS bf16x8*)(lds + PG8_SB(b, h) + boff + n * 2048 + k * 1024); } while (0)
#define PG8_MMA(ai, bj, At, Bt) do { __builtin_amdgcn_s_setprio(1); _Pragma("unroll") for (int m = 0; m < 4; ++m) _Pragma("unroll") for (int n = 0; n < 2; ++n) _Pragma("unroll") for (int k = 0; k < 2; ++k) \
        acc[ai][bj][m][n] = __builtin_amdgcn_mfma_f32_16x16x32_bf16(Bt[n][k], At[m][k], acc[ai][bj][m][n], 0, 0, 0); __builtin_amdgcn_s_setprio(0); } while (0)
#define PG8_WAIT_V(n) asm volatile("s_waitcnt vmcnt(" #n ")" ::: "memory")
#define PG8_WAIT_L(n) asm volatile("s_waitcnt lgkmcnt(" #n ")" ::: "memory")
#define PG8_BAR __builtin_amdgcn_s_barrier()
#define PG8_SCHED __builtin_amdgcn_sched_barrier(0)
    Unit cur, nxt; int ui = 0;
    if (!S.next(0, cur)) return;
    f32x4 acc[2][2][4][2];
#pragma unroll
    for (int a = 0; a < 2; ++a)
#pragma unroll
        for (int b = 0; b < 2; ++b)
#pragma unroll
            for (int m = 0; m < 4; ++m)
#pragma unroll
                for (int n = 0; n < 2; ++n) acc[a][b][m][n] = (f32x4){0.f, 0.f, 0.f, 0.f};
    bf16x8 At[4][2], B0[2][2], B1[2][2];
    const char* cA = (const char*)g.A + (size_t)cur.pm * tstep; const char* cB = (const char*)g.Bt + (size_t)cur.pn * tstep;
    PG8_STAGE(PG8_SB(0, 0), cB, voffB); PG8_STAGE(PG8_SA(0, 0), cA, voffA); PG8_STAGE(PG8_SB(0, 1), cB + hstep, voffB); PG8_STAGE(PG8_SA(0, 1), cA + hstep, voffA);
    if (wr == 1) PG8_BAR;
    PG8_WAIT_V(4); PG8_BAR;
    PG8_STAGE(PG8_SB(1, 0), cB + kstep, voffB); PG8_STAGE(PG8_SA(1, 0), cA + kstep, voffA); PG8_STAGE(PG8_SB(1, 1), cB + hstep + kstep, voffB);
    PG8_WAIT_V(6); PG8_BAR;
    for (;;) {
        const bool has_next = S.next(ui + 1, nxt);
        const char* nA = has_next ? (const char*)g.A + (size_t)nxt.pm * tstep : cA; const char* nB = has_next ? (const char*)g.Bt + (size_t)nxt.pn * tstep : cB;
        for (int t = 0; t < nt; t += 2) {
            const bool last = (t == nt - 2);
            const char* a1 = cA + (size_t)(t + 1) * kstep;
            const char* a2 = last ? nA : cA + (size_t)(t + 2) * kstep; const char* b2 = last ? nB : cB + (size_t)(t + 2) * kstep;
            const char* a3 = a2 + kstep; const char* b3 = b2 + kstep;
            PG8_LDB(B0, 0, 0); PG8_SCHED; PG8_LDA(At, 0, 0); PG8_STAGE(PG8_SA(1, 1), a1 + hstep, voffA);
            PG8_WAIT_L(8); PG8_BAR; PG8_WAIT_L(0); PG8_MMA(0, 0, At, B0); PG8_BAR; PG8_SCHED;
            PG8_LDB(B1, 0, 1); PG8_STAGE(PG8_SB(0, 0), b2, voffB);
            PG8_BAR; PG8_WAIT_L(0); PG8_MMA(0, 1, At, B1); PG8_BAR;
            PG8_LDA(At, 0, 1); PG8_STAGE(PG8_SA(0, 0), a2, voffA);
            PG8_BAR; PG8_WAIT_L(0); PG8_MMA(1, 0, At, B0); PG8_BAR; PG8_SCHED;
            PG8_STAGE(PG8_SB(0, 1), b2 + hstep, voffB);
            PG8_WAIT_V(6); PG8_BAR; PG8_MMA(1, 1, At, B1); PG8_BAR;
            PG8_LDB(B0, 1, 0); PG8_SCHED; PG8_LDA(At, 1, 0); PG8_STAGE(PG8_SA(0, 1), a2 + hstep, voffA);
            PG8_WAIT_L(8); PG8_BAR; PG8_WAIT_L(0); PG8_MMA(0, 0, At, B0); PG8_BAR; PG8_SCHED;
            PG8_LDB(B1, 1, 1); PG8_STAGE(PG8_SB(1, 0), b3, voffB);
            PG8_BAR; PG8_WAIT_L(0); PG8_MMA(0, 1, At, B1); PG8_BAR;
            PG8_LDA(At, 1, 1); PG8_STAGE(PG8_SA(1, 0), a3, voffA);
            PG8_BAR; PG8_WAIT_L(0); PG8_MMA(1, 0, At, B0); PG8_BAR; PG8_SCHED;
            PG8_STAGE(PG8_SB(1, 1), b3 + hstep, voffB);
            PG8_WAIT_V(6); PG8_BAR; PG8_MMA(1, 1, At, B1); PG8_BAR;
        }
        E(acc, cur, wr, wc, fr, fq);
        if (!has_next) break;
#pragma unroll
        for (int a = 0; a < 2; ++a)
#pragma unroll
            for (int b = 0; b < 2; ++b)
#pragma unroll
                for (int m = 0; m < 4; ++m)
#pragma unroll
                    for (int n = 0; n < 2; ++n) acc[a][b][m][n] = (f32x4){0.f, 0.f, 0.f, 0.f};
        cur = nxt; cA = nA; cB = nB; ++ui;
    }
    PG8_WAIT_V(0);
    if (wr == 0) PG8_BAR;
    PG8_BAR;
#undef PG8_SA
#undef PG8_SB
#undef PG8_STAGE
#undef PG8_LDA
#undef PG8_LDB
#undef PG8_MMA
#undef PG8_WAIT_V
#undef PG8_WAIT_L
#undef PG8_BAR
#undef PG8_SCHED
}
}

struct EpiT {
    int mode;
    int g, l;
    const float* rs; float* rs_out;
    int first;
    int wxb;
    __device__ __forceinline__ bool perm() const { return mode != 4; }
    __device__ __forceinline__ void res(const f32x4 (&acc)[2][2][4][2], const pg8::Unit& u, int wr, int wc, int fr, int fq) const {
        float* out = OUTP(); bf16_t* xb = (bf16_t*)(WSP() + WS_XB);
        const int row0 = u.pm * 256 + wr * 64 + fr, col0 = u.pn * 256 + wc * 32 + 4 * fq;
#pragma unroll
        for (int ai = 0; ai < 2; ++ai) {
            f32x4 xin[4][2][2];
#pragma unroll
            for (int m = 0; m < 4; ++m) {
                const int r = row0 + ai * 128 + m * 16;
                const bool ok = row_valid(g, r);
                const int rq = ok ? r : 0;
                const float* yp = (first ? (rq < 32768 ? INP(0) + ((size_t)g * 32768 + rq) * 1024 : INP(1) + (size_t)(rq - 32768) * 1024) : (const float*)yrow(out, g, rq)) + col0;
#pragma unroll
                for (int bj = 0; bj < 2; ++bj)
#pragma unroll
                    for (int n = 0; n < 2; ++n) xin[m][bj][n] = ok ? *(const f32x4*)(yp + bj * 128 + n * 16) : (f32x4){0.f, 0.f, 0.f, 0.f};
            }
#pragma unroll
            for (int m = 0; m < 4; ++m) {
                const int r = row0 + ai * 128 + m * 16;
                const bool ok = row_valid(g, r);
                float* yp = yrow(out, g, ok ? r : 0) + col0;
                bf16_t* xp = xb + (size_t)r * 1024 + col0;
                float ss = 0.f;
#pragma unroll
                for (int bj = 0; bj < 2; ++bj)
#pragma unroll
                    for (int n = 0; n < 2; ++n) {
                        const f32x4 x = xin[m][bj][n] + acc[ai][bj][m][n];
                        if (ok) {
                            *(f32x4*)(yp + bj * 128 + n * 16) = x;
                            if (wxb) { u32x2 w; w.x = cvt_pk_bf16(x[0], x[1]); w.y = cvt_pk_bf16(x[2], x[3]); *(u32x2*)(xp + bj * 128 + n * 16) = w; }
                            ss += (x[0] * x[0] + x[1] * x[1]) + (x[2] * x[2] + x[3] * x[3]);
                        }
                    }
                ss += __shfl_xor(ss, 16); ss += __shfl_xor(ss, 32);
                if (ok && fq == 0) atomicAdd(rs_out + r, ss);
            }
        }
    }
    __device__ __forceinline__ void epi_proj(const f32x4 (&acc)[2][2][4][2], const pg8::Unit& u, int wr, int wc, int fr, int fq) const {
        bf16_t* act = (bf16_t*)(WSP() + WS_ACT); bf16_t* H = act; bf16_t* halo = (bf16_t*)(WSP() + WS_HALO); float* bg = (float*)(WSP() + WS_BG); float* out = OUTP();
        const float* a_log = INP(11); const float* dt_bias = INP(12);
        const int row0 = u.pm * 256 + wr * 64 + fr;
        const int colt = u.pn * 256 + wc * 32 + 8 * fq;
        float rstd8[2][4];
#pragma unroll
        for (int ai = 0; ai < 2; ++ai)
#pragma unroll
            for (int m = 0; m < 4; ++m) rstd8[ai][m] = rs[row0 + ai * 128 + m * 16];
#pragma unroll
        for (int ai = 0; ai < 2; ++ai)
#pragma unroll
            for (int m = 0; m < 4; ++m) rstd8[ai][m] = rsqrtf(rstd8[ai][m] * (1.0f / 1024.0f) + EPS);
#pragma unroll
        for (int ai = 0; ai < 2; ++ai)
#pragma unroll
            for (int m = 0; m < 4; ++m) {
                const int r = row0 + ai * 128 + m * 16;
                    const float rstd = rstd8[ai][m];
                    if (u.pn == 32) {
                        if (wc == 0 && fq < 2) {
                            const f32x4 v0 = acc[ai][0][m][0] * rstd, v1 = acc[ai][0][m][1] * rstd;
                            float o8[8] = {v0[0], v0[1], v0[2], v0[3], v1[0], v1[1], v1[2], v1[3]};
#pragma unroll
                            for (int h = 0; h < 8; ++h) {
                                if (fq == 0) o8[h] = sigmoidf_(o8[h]);
                                else { const float xx = o8[h] + dt_bias[l * 8 + h]; const float sp = xx > 20.f ? xx : log1pf(__expf(xx)); o8[h] = -__expf(a_log[l * 8 + h]) * sp; }
                            }
                            float* dst = bg + (size_t)r * 16 + 8 * fq;
                            *(f32x4*)dst = (f32x4){o8[0], o8[1], o8[2], o8[3]}; *(f32x4*)(dst + 4) = (f32x4){o8[4], o8[5], o8[6], o8[7]};
                        }
                    } else {
                        const int slot = u.pn >> 2;
                        bf16_t* rowp = act + (size_t)slot * SLOT_EL + (size_t)r * 1024 + (colt & 1023);
#pragma unroll
                        for (int bj = 0; bj < 2; ++bj) {
                            f32x4 v0 = acc[ai][bj][m][0] * rstd, v1 = acc[ai][bj][m][1] * rstd;
                            if (slot < 2) {
                                f32x2 a = gelu_pk((f32x2){v0[0], v0[1]}), b = gelu_pk((f32x2){v0[2], v0[3]}), c = gelu_pk((f32x2){v1[0], v1[1]}), d = gelu_pk((f32x2){v1[2], v1[3]});
                                v0 = (f32x4){a.x, a.y, b.x, b.y}; v1 = (f32x4){c.x, c.y, d.x, d.y};
                            } else if (slot == 5) {
#pragma unroll
                                for (int j = 0; j < 4; ++j) { v0[j] = siluf_(v0[j]); v1[j] = siluf_(v1[j]); }
                            } else if (slot >= 6) {
#pragma unroll
                                for (int j = 0; j < 4; ++j) { v0[j] = sigmoidf_(v0[j]); v1[j] = sigmoidf_(v1[j]); }
                            }
                            u32x4 w; w.x = cvt_pk_bf16(v0[0], v0[1]); w.y = cvt_pk_bf16(v0[2], v0[3]); w.z = cvt_pk_bf16(v1[0], v1[1]); w.w = cvt_pk_bf16(v1[2], v1[3]);
                            *(u32x4*)(rowp + bj * 128) = w;
                            if (slot >= 2 && slot <= 4) {
                                const int ch = (slot - 2) * 1024 + (colt & 1023) + bj * 128;
                                if ((r & 63) >= 61) *(u32x4*)(halo + ((size_t)(r >> 6) * 3 + ((r & 63) - 61)) * 3072 + ch) = w;
                                float* cdst = nullptr;
                                if (r < 32768) { if ((r & 4095) >= 4093) cdst = out + OCP + (((size_t)l * 16 + g * 8 + (r >> 12)) * 3 + ((r & 4095) - 4093)) * 3072 + ch; }
                                else if (g == 0 && r < 32896) { const int rr = r - 32768; if ((rr & 15) >= 13) cdst = out + OCS + (((size_t)l * 8 + (rr >> 4)) * 3 + ((rr & 15) - 13)) * 3072 + ch; }
                                if (cdst) { *(f32x4*)cdst = v0; *(f32x4*)(cdst + 4) = v1; }
                            }
                        }
                    }
            }
    }
    __device__ __forceinline__ void epi_up(const f32x4 (&acc)[2][2][4][2], const pg8::Unit& u, int wr, int wc, int fr, int fq) const {
        bf16_t* act = (bf16_t*)(WSP() + WS_ACT); bf16_t* H = act; bf16_t* halo = (bf16_t*)(WSP() + WS_HALO); float* bg = (float*)(WSP() + WS_BG); float* out = OUTP();
        const float* a_log = INP(11); const float* dt_bias = INP(12);
        const int row0 = u.pm * 256 + wr * 64 + fr;
        const int colt = u.pn * 256 + wc * 32 + 8 * fq;
        float rstd8[2][4];
#pragma unroll
        for (int ai = 0; ai < 2; ++ai)
#pragma unroll
            for (int m = 0; m < 4; ++m) rstd8[ai][m] = rs[row0 + ai * 128 + m * 16];
#pragma unroll
        for (int ai = 0; ai < 2; ++ai)
#pragma unroll
            for (int m = 0; m < 4; ++m) rstd8[ai][m] = rsqrtf(rstd8[ai][m] * (1.0f / 1024.0f) + EPS);
#pragma unroll
        for (int ai = 0; ai < 2; ++ai)
#pragma unroll
            for (int m = 0; m < 4; ++m) {
                const int r = row0 + ai * 128 + m * 16;
                    const float rstd = rstd8[ai][m];
                    bf16_t* rowp = H + (size_t)r * 4096 + colt;
#pragma unroll
                    for (int bj = 0; bj < 2; ++bj) {
                        f32x4 v0 = acc[ai][bj][m][0] * rstd, v1 = acc[ai][bj][m][1] * rstd;
#pragma unroll
                        for (int j = 0; j < 4; ++j) { v0[j] = fmaxf(v0[j], 0.f); v0[j] *= v0[j]; v1[j] = fmaxf(v1[j], 0.f); v1[j] *= v1[j]; }
                        u32x4 w; w.x = cvt_pk_bf16(v0[0], v0[1]); w.y = cvt_pk_bf16(v0[2], v0[3]); w.z = cvt_pk_bf16(v1[0], v1[1]); w.w = cvt_pk_bf16(v1[2], v1[3]);
                        *(u32x4*)(rowp + bj * 128) = w;
                    }
            }
    }
    __device__ __forceinline__ void epi_gate(const f32x4 (&acc)[2][2][4][2], const pg8::Unit& u, int wr, int wc, int fr, int fq) const {
        bf16_t* act = (bf16_t*)(WSP() + WS_ACT);
        const int row0 = u.pm * 256 + wr * 64 + fr;
        const int colt = u.pn * 256 + wc * 32 + 8 * fq;
#pragma unroll
        for (int ai = 0; ai < 2; ++ai) {
            u32x4 gw[4][2], tw[4][2];
#pragma unroll
            for (int m = 0; m < 4; ++m) {
                const int r = row0 + ai * 128 + m * 16;
                const bf16_t* ga = act + (size_t)6 * SLOT_EL + (size_t)r * 1024 + colt;
                const bf16_t* gb = act + (size_t)7 * SLOT_EL + (size_t)r * 1024 + colt;
#pragma unroll
                for (int bj = 0; bj < 2; ++bj) { gw[m][bj] = *(const u32x4*)((mode == 1 ? ga : gb) + bj * 128); tw[m][bj] = mode == 2 ? *(const u32x4*)(ga + bj * 128) : (u32x4){0u, 0u, 0u, 0u}; }
            }
#pragma unroll
            for (int m = 0; m < 4; ++m) {
                const int r = row0 + ai * 128 + m * 16;
                bf16_t* dst = act + (size_t)(mode == 1 ? 6 : 7) * SLOT_EL + (size_t)r * 1024 + colt;
#pragma unroll
                for (int bj = 0; bj < 2; ++bj) {
                    const f32x4 a0 = acc[ai][bj][m][0], a1 = acc[ai][bj][m][1];
                    const u32x4 g4 = gw[m][bj], t4 = tw[m][bj];
                    float o[8] = {a0[0] * bflo(g4.x), a0[1] * bfhi(g4.x), a0[2] * bflo(g4.y), a0[3] * bfhi(g4.y), a1[0] * bflo(g4.z), a1[1] * bfhi(g4.z), a1[2] * bflo(g4.w), a1[3] * bfhi(g4.w)};
                    o[0] += bflo(t4.x); o[1] += bfhi(t4.x); o[2] += bflo(t4.y); o[3] += bfhi(t4.y); o[4] += bflo(t4.z); o[5] += bfhi(t4.z); o[6] += bflo(t4.w); o[7] += bfhi(t4.w);
                    u32x4 w; w.x = cvt_pk_bf16(o[0], o[1]); w.y = cvt_pk_bf16(o[2], o[3]); w.z = cvt_pk_bf16(o[4], o[5]); w.w = cvt_pk_bf16(o[6], o[7]);
                    *(u32x4*)(dst + bj * 128) = w;
                }
            }
        }
    }
    __device__ __forceinline__ void operator()(const f32x4 (&acc)[2][2][4][2], const pg8::Unit& u, int wr, int wc, int fr, int fq) const {
        if (mode == 4) res(acc, u, wr, wc, fr, fq);
        else if (mode == 0) epi_proj(acc, u, wr, wc, fr, fq);
        else if (mode == 3) epi_up(acc, u, wr, wc, fr, fq);
        else epi_gate(acc, u, wr, wc, fr, fq);
    }
};

__device__ __forceinline__ void win_map(int nd, int& ns, int& nv) {
    if (nd < 6144) { ns = nd; nv = 64; } else if (nd < 8192) { ns = nd + 16; nv = 64; } else if (nd == 8192) { ns = 6144; nv = 16; } else { ns = 0; nv = 0; }
}
__device__ __forceinline__ void wconv_strip(const float* W, int ldw, int k0, int nd0, bool winmap, const float* kscale, bf16_t* Bt, int K, unsigned char* lds, const int tidx) {
    bf16_t* tile = (bf16_t*)lds;
    const int t = tidx;
    { const int k = t >> 3, n0 = (t & 7) * 8;
      f32x4 a[4], b[4];
#pragma unroll
      for (int q = 0; q < 4; ++q) {
          int ns = nd0 + 64 * q, nv = 64; if (winmap) win_map(nd0 + 64 * q, ns, nv);
          a[q] = (f32x4){0.f, 0.f, 0.f, 0.f}; b[q] = a[q];
          if (n0 < nv) { const float* src = W + (size_t)(k0 + k) * ldw + ns + n0; a[q] = *(const f32x4*)src; b[q] = *(const f32x4*)(src + 4); }
      }
      const float sc = kscale ? kscale[k0 + k] : 1.0f;
#pragma unroll
      for (int q = 0; q < 4; ++q) {
          float v[8] = {a[q][0], a[q][1], a[q][2], a[q][3], b[q][0], b[q][1], b[q][2], b[q][3]};
#pragma unroll
          for (int i = 0; i < 8; ++i) tile[(q * 64 + n0 + i) * 72 + k] = f2bf(v[i] * sc);
      }
    }
    __syncthreads();
    { const int n = t >> 3, kk = (t & 7) * 8;
#pragma unroll
      for (int q = 0; q < 4; ++q) *(u32x4*)(Bt + (size_t)(nd0 + 64 * q + n) * K + k0 + kk) = *(const u32x4*)(tile + (q * 64 + n) * 72 + kk); }
    __syncthreads();
}
__device__ __forceinline__ void phase_wconv(const Params& p, unsigned char* lds, const int tidx) {
    bf16_t* WT = (bf16_t*)(WSP() + WS_W);
    for (int j = blockIdx.x; j < 2 * 1232; j += gridDim.x) {
        const int l = j / 1232; int jj = j % 1232;
        bf16_t* wl = WT + (size_t)l * W_LAYER;
        if (jj < 528) {
            const int st = jj >> 4, kt = jj & 15;
            wconv_strip(INP(5) + (size_t)l * 1024 * NIN, NIN, kt * 64, st * 256, true, INP(4) + l * 1024, wl + W_IN, 1024, lds, tidx);
        } else if (jj < 528 + 192) {
            jj -= 528; const int which = jj >> 6; jj &= 63; const int st = jj >> 4, kt = jj & 15;
            const float* src = INP(14 + which) + (size_t)l * 1048576;
            wconv_strip(src, 1024, kt * 64, st * 256, false, nullptr, wl + (which == 0 ? W_PA : which == 1 ? W_PB : W_WO), 1024, lds, tidx);
        } else if (jj < 528 + 192 + 256) {
            jj -= 720; const int st = jj >> 4, kt = jj & 15;
            wconv_strip(INP(18) + (size_t)l * 4194304, 4096, kt * 64, st * 256, false, INP(17) + l * 1024, wl + W_UP, 1024, lds, tidx);
        } else {
            jj -= 976; const int st = jj >> 6, kt = jj & 63;
            wconv_strip(INP(19) + (size_t)l * 4194304, 1024, kt * 64, st * 256, false, nullptr, wl + W_DN, 4096, lds, tidx);
        }
    }
    float* rs = (float*)(WSP() + WS_RS);
    for (int i = blockIdx.x * NTHREADS + tidx; i < 10 * TGMAX; i += gridDim.x * NTHREADS) if ((i / TGMAX) % 5 != 0) rs[i] = 0.f;
}

__device__ __forceinline__ void phase_s0(const Params& p, int g, int Tg, const int tidx) {
    bf16_t* XB = (bf16_t*)(WSP() + WS_XB); float* rs = (float*)(WSP() + WS_RS) + (size_t)(g * 5) * TGMAX;
    const int lane = tidx & 63, wv = blockIdx.x * 8 + (tidx >> 6);
    for (int r = wv; r < Tg; r += gridDim.x * 8) {
        const bool ok = row_valid(g, r);
        float ss = 0.f;
        if (ok) {
            const float* src = r < 32768 ? INP(0) + ((size_t)g * 32768 + r) * 1024 : INP(1) + (size_t)(r - 32768) * 1024;
#pragma unroll
            for (int i = 0; i < 4; ++i) {
                const f32x4 x = *(const f32x4*)(src + 4 * lane + 256 * i);
                u32x2 w; w.x = cvt_pk_bf16(x[0], x[1]); w.y = cvt_pk_bf16(x[2], x[3]);
                *(u32x2*)(XB + (size_t)r * 1024 + 4 * lane + 256 * i) = w;
                ss += (x[0] * x[0] + x[1] * x[1]) + (x[2] * x[2] + x[3] * x[3]);
            }
        } else {
#pragma unroll
            for (int i = 0; i < 4; ++i) *(u32x2*)(XB + (size_t)r * 1024 + 4 * lane + 256 * i) = (u32x2){0u, 0u};
        }
        ss = wave_sum(ss);
        if (lane == 0) rs[r] = ss;
    }
}
__device__ __forceinline__ void phase_final(const Params& p, int g, int Tg, const int tidx) {
    const float* rs = (const float*)(WSP() + WS_RS) + (size_t)(g * 5 + 4) * TGMAX; const float* fn = INP(20);
    const int lane = tidx & 63, wv = blockIdx.x * 8 + (tidx >> 6);
    for (int r = wv; r < Tg; r += gridDim.x * 8) {
        if (!row_valid(g, r)) continue;
        const float rstd = rsqrtf(rs[r] * (1.0f / 1024.0f) + EPS);
        float* dst = yrow(OUTP(), g, r);
#pragma unroll
        for (int i = 0; i < 4; ++i) { const int c = 4 * lane + 256 * i; f32x4 x = *(const f32x4*)(dst + c); const f32x4 w = *(const f32x4*)(fn + c); *(f32x4*)(dst + c) = x * rstd * w; }
    }
}

__device__ __forceinline__ f32x4 mma(bf16x8 x, bf16x8 y, f32x4 c) { return __builtin_amdgcn_mfma_f32_16x16x32_bf16(x, y, c, 0, 0, 0); }

__device__ __forceinline__ void gmlp_unit(const Params& p, int g, int l, int ci, unsigned char* lds, const int tidx) {
    bf16_t* U = (bf16_t*)(WSP() + WS_ACT); const bf16_t* VA = U + SLOT_EL;
    bf16_t* sVT = (bf16_t*)lds;
    bf16_t* sWs = (bf16_t*)(lds + 34816);
    f32x2* sStat = (f32x2*)(lds + 69632);
    const int tid = tidx, wid = __builtin_amdgcn_readfirstlane(tid >> 6), lane = tid & 63, fr = lane & 15, fq = lane >> 4;
    const bool smp = ci >= 256; const int sb = ci - 256;
    const int row0 = smp ? 32768 + 16 * sb : 128 * ci, nvalid = smp ? 16 : 128;
    const float* lng = INP(6) + l * 1024; const float* lnb = INP(7) + l * 1024;
    for (int i4 = 0; i4 < 16; i4 += 4) {
        u32x4 ra[4], rb[4];
#pragma unroll
        for (int k = 0; k < 4; ++k) {
            const int rr = wid * 16 + i4 + k; const int rc = rr < nvalid ? rr : 0;
            const bf16_t* src = VA + (size_t)(row0 + rc) * 1024;
            ra[k] = *(const u32x4*)(src + 8 * lane); rb[k] = *(const u32x4*)(src + 512 + 8 * lane);
        }
#pragma unroll
        for (int k = 0; k < 4; ++k) {
            const int rr = wid * 16 + i4 + k;
            const u32x4 a = ra[k], b = rb[k];
            float v[16] = {bflo(a.x), bfhi(a.x), bflo(a.y), bfhi(a.y), bflo(a.z), bfhi(a.z), bflo(a.w), bfhi(a.w), bflo(b.x), bfhi(b.x), bflo(b.y), bfhi(b.y), bflo(b.z), bfhi(b.z), bflo(b.w), bfhi(b.w)};
            float s = 0.f;
#pragma unroll
            for (int q = 0; q < 16; ++q) s += v[q];
            const float mean = wave_sum(s) * (1.0f / 1024.0f);
            float q2 = 0.f;
#pragma unroll
            for (int q = 0; q < 16; ++q) { const float d = v[q] - mean; q2 += d * d; }
            const float rstd = rsqrtf(wave_sum(q2) * (1.0f / 1024.0f) + EPS);
            if (lane == 0) sStat[rr] = rr < nvalid ? (f32x2){mean, rstd} : (f32x2){0.f, 0.f};
            if (smp && rr < nvalid) {
                float* dst = OUTP() + OGV + (((size_t)l * 8 + sb) * 16 + rr) * 1024;
#pragma unroll
                for (int hh = 0; hh < 2; ++hh) { const int c = 512 * hh + 8 * lane;
                    const f32x4 g0 = *(const f32x4*)(lng + c), g1 = *(const f32x4*)(lng + c + 4), b0 = *(const f32x4*)(lnb + c), b1 = *(const f32x4*)(lnb + c + 4);
                    f32x4 o0, o1;
#pragma unroll
                    for (int q = 0; q < 4; ++q) { o0[q] = (v[8 * hh + q] - mean) * rstd * g0[q] + b0[q]; o1[q] = (v[8 * hh + 4 + q] - mean) * rstd * g1[q] + b1[q]; }
                    *(f32x4*)(dst + c) = o0; *(f32x4*)(dst + c + 4) = o1; }
            }
        }
    }
    __syncthreads();
    for (int grp = 0; grp < 8; ++grp) {
        { const float* ws = INP(8) + ((size_t)l * 8 + grp) * 16384; const int t = tid >> 2, s0 = 32 * (tid & 3);
#pragma unroll
          for (int k = 0; k < 4; ++k) {
              f32x4 a = (f32x4){0.f, 0.f, 0.f, 0.f}, b = a;
              if (t < nvalid && s0 + 8 * k <= t) { a = *(const f32x4*)(ws + t * 128 + s0 + 8 * k); b = *(const f32x4*)(ws + t * 128 + s0 + 8 * k + 4); }
              float v[8] = {a[0], a[1], a[2], a[3], b[0], b[1], b[2], b[3]};
#pragma unroll
              for (int i = 0; i < 8; ++i) if (s0 + 8 * k + i > t) v[i] = 0.f;
              u32x4 w; w.x = cvt_pk_bf16(v[0], v[1]); w.y = cvt_pk_bf16(v[2], v[3]); w.z = cvt_pk_bf16(v[4], v[5]); w.w = cvt_pk_bf16(v[6], v[7]);
              *(u32x4*)(sWs + t * 136 + s0 + 8 * k) = w;
          } }
        { const int s = tid & 127, oct = tid >> 7; const f32x2 st = sStat[s];
#pragma unroll
          for (int ps = 0; ps < 4; ++ps) {
              const int c0 = 8 * (oct + 4 * ps), cg = grp * 128 + c0;
              float v[8] = {0.f, 0.f, 0.f, 0.f, 0.f, 0.f, 0.f, 0.f};
              if (s < nvalid) {
                  const u32x4 a = *(const u32x4*)(VA + (size_t)(row0 + s) * 1024 + cg);
                  const f32x4 g0 = *(const f32x4*)(lng + cg), g1 = *(const f32x4*)(lng + cg + 4), b0 = *(const f32x4*)(lnb + cg), b1 = *(const f32x4*)(lnb + cg + 4);
                  v[0] = (bflo(a.x) - st.x) * st.y * g0[0] + b0[0]; v[1] = (bfhi(a.x) - st.x) * st.y * g0[1] + b0[1];
                  v[2] = (bflo(a.y) - st.x) * st.y * g0[2] + b0[2]; v[3] = (bfhi(a.y) - st.x) * st.y * g0[3] + b0[3];
                  v[4] = (bflo(a.z) - st.x) * st.y * g1[0] + b1[0]; v[5] = (bfhi(a.z) - st.x) * st.y * g1[1] + b1[1];
                  v[6] = (bflo(a.w) - st.x) * st.y * g1[2] + b1[2]; v[7] = (bfhi(a.w) - st.x) * st.y * g1[3] + b1[3];
              }
#pragma unroll
              for (int i = 0; i < 8; ++i) sVT[(c0 + i) * 136 + s] = f2bf(v[i]);
          } }
        __syncthreads();
        { const int tb = wid >> 1, t0 = 32 * tb, c0 = 64 * (wid & 1);
          f32x4 acc[2][4];
#pragma unroll
          for (int a = 0; a < 2; ++a)
#pragma unroll
              for (int b = 0; b < 4; ++b) acc[a][b] = (f32x4){0.f, 0.f, 0.f, 0.f};
          for (int kk = 0; kk <= tb; ++kk) {
              bf16x8 yf[2], xf[4];
#pragma unroll
              for (int a = 0; a < 2; ++a) yf[a] = *(const bf16x8*)(sWs + (t0 + 16 * a + fr) * 136 + 32 * kk + 8 * fq);
#pragma unroll
              for (int b = 0; b < 4; ++b) xf[b] = *(const bf16x8*)(sVT + (c0 + 16 * b + fr) * 136 + 32 * kk + 8 * fq);
#pragma unroll
              for (int a = 0; a < 2; ++a)
#pragma unroll
                  for (int b = 0; b < 4; ++b) acc[a][b] = mma(xf[b], yf[a], acc[a][b]);
          }
#pragma unroll
          for (int a = 0; a < 2; ++a) {
              const int t = t0 + 16 * a + fr;
              if (t < nvalid) {
                  const float bs = INP(9)[((size_t)l * 8 + grp) * 128 + t];
#pragma unroll
                  for (int b = 0; b < 4; ++b) {
                      bf16_t* up = U + (size_t)(row0 + t) * 1024 + grp * 128 + c0 + 16 * b + 4 * fq;
                      const u32x2 uw = *(const u32x2*)up;
                      u32x2 w; w.x = cvt_pk_bf16(bflo(uw.x) * (acc[a][b][0] + bs), bfhi(uw.x) * (acc[a][b][1] + bs)); w.y = cvt_pk_bf16(bflo(uw.y) * (acc[a][b][2] + bs), bfhi(uw.y) * (acc[a][b][3] + bs));
                      *(u32x2*)up = w;
                  }
              }
          } }
        __syncthreads();
    }
}


template <int I>
__device__ __forceinline__ void solve_rows(float (&x)[64], const f32x4* A4, const bf16_t* src, const float* sBeta, const float* sGam, int part, bf16_t* dst, int nvalid) {
    if constexpr (I < 64) {
        f32x4 a4[(I + 3) / 4 + 1];
#pragma unroll
        for (int q = 0; q < (I + 3) / 4; ++q) a4[q] = A4[I * 16 + q];
        float a = bf2f(src[I * 136]) * sBeta[I];
        if (part == 1) a *= __expf(sGam[I]);
#pragma unroll
        for (int j = 0; j < I; ++j) a -= a4[j >> 2][j & 3] * x[j];
        x[I] = a;
        if (I < nvalid) *dst = f2bf(a);
        dst += 1024;
        asm volatile("" : "+v"(dst) :: "memory");
        solve_rows<I + 1>(x, A4, src, sBeta, sGam, part, dst, nvalid);
    }
}

__device__ __forceinline__ void d1_unit(const Params& p, int g, int l, int unit0, int nd1, unsigned char* lds0, const int tidx) {
    const int half = __builtin_amdgcn_readfirstlane(tidx >> 8), tid = tidx & 255, wid = __builtin_amdgcn_readfirstlane((tidx >> 6) & 3), lane = tidx & 63, fr = lane & 15, fq = lane >> 4;
    const int unit_raw = unit0 + half * (int)gridDim.x;
    const bool active = unit_raw < nd1;
    const int unit = active ? unit_raw : unit0;
    unsigned char* lds = lds0 + half * 69632;
    bf16_t* ACT = (bf16_t*)(WSP() + WS_ACT);
    bf16_t* Qb = ACT + 2 * SLOT_EL; bf16_t* Kb = ACT + 3 * SLOT_EL; bf16_t* Vb = ACT + 4 * SLOT_EL;
    bf16_t* KGT = (bf16_t*)(WSP() + WS_KGT) + (size_t)unit * 8192;
    bf16_t* Pm = (bf16_t*)(WSP() + WS_P) + (size_t)unit * 4096;
    const bf16_t* HALO = (const bf16_t*)(WSP() + WS_HALO);
    const float* BG = (const float*)(WSP() + WS_BG); float* GL = (float*)(WSP() + WS_GL);
    bf16_t* sq = (bf16_t*)lds; bf16_t* sk = sq + 64 * 136; bf16_t* sv = sk + 64 * 136;
    float* Am = (float*)(lds + 52224);
    float* sGam = (float*)(lds + 68608); float* sBeta = sGam + 64;
    const int cid = unit >> 3, h = unit & 7;
    const bool smp = cid >= 512; const int sb = cid - 512;
    const int row0 = smp ? 32768 + 16 * sb : 64 * cid, nvalid = smp ? 16 : 64;
    const int nloc = smp ? 0 : (cid & 63);
    if (active) for (int pass = 0; pass < 2; ++pass) { const int c = (tid >> 3) + 32 * pass, sub = tid & 7, d0 = 16 * sub;
      const f32x4* sCW = (const f32x4*)(lds0 + 139264);
      u32x4 raw[3][4][2];
#pragma unroll
      for (int X = 0; X < 3; ++X) {
          const bf16_t* buf = X == 0 ? Qb : (X == 1 ? Kb : Vb);
          const int chx = X * 1024 + 128 * h + d0;
#pragma unroll
          for (int j = 0; j < 4; ++j) {
              const int rr = c - 3 + j;
              raw[X][j][0] = (u32x4){0u, 0u, 0u, 0u}; raw[X][j][1] = raw[X][j][0];
              if (c < nvalid) {
                  if (rr >= 0) { const bf16_t* src = buf + (size_t)(row0 + rr) * 1024 + 128 * h + d0; raw[X][j][0] = *(const u32x4*)src; raw[X][j][1] = *(const u32x4*)(src + 8); }
                  else if (smp) {
                      const float* src = INP(2) + (((size_t)l * 8 + sb) * 3 + (rr + 3)) * 3072 + chx;
                      const f32x4 f0 = *(const f32x4*)src, f1 = *(const f32x4*)(src + 4), f2 = *(const f32x4*)(src + 8), f3 = *(const f32x4*)(src + 12);
                      raw[X][j][0] = (u32x4){cvt_pk_bf16(f0[0], f0[1]), cvt_pk_bf16(f0[2], f0[3]), cvt_pk_bf16(f1[0], f1[1]), cvt_pk_bf16(f1[2], f1[3])};
                      raw[X][j][1] = (u32x4){cvt_pk_bf16(f2[0], f2[1]), cvt_pk_bf16(f2[2], f2[3]), cvt_pk_bf16(f3[0], f3[1]), cvt_pk_bf16(f3[2], f3[3])};
                  } else if (nloc > 0) { const bf16_t* src = HALO + ((size_t)(cid - 1) * 3 + (rr + 3)) * 3072 + chx; raw[X][j][0] = *(const u32x4*)src; raw[X][j][1] = *(const u32x4*)(src + 8); }
              }
          }
      }
#pragma unroll
      for (int X = 0; X < 3; ++X) {
          float y[16];
#pragma unroll
          for (int i = 0; i < 16; ++i) {
              const f32x4 w = sCW[X * 128 + d0 + i];
              float acc = 0.f;
#pragma unroll
              for (int j = 0; j < 4; ++j) { const unsigned wd = raw[X][j][i >> 3][(i >> 1) & 3]; acc += ((i & 1) ? bfhi(wd) : bflo(wd)) * w[j]; }
              y[i] = c < nvalid ? siluf_(acc) : 0.f;
          }
          if (X < 2) {
              float ss = 0.f;
#pragma unroll
              for (int i = 0; i < 16; ++i) ss += y[i] * y[i];
              ss += __shfl_xor(ss, 1); ss += __shfl_xor(ss, 2); ss += __shfl_xor(ss, 4);
              const float sc = rsqrtf(ss + EPS) * (X == 0 ? 0.08838834764831845f : 1.0f);
#pragma unroll
              for (int i = 0; i < 16; ++i) y[i] *= sc;
          }
          bf16_t* dst = (X == 0 ? sq : (X == 1 ? sk : sv)) + c * 136 + d0;
          u32x4 w0, w1;
          w0.x = cvt_pk_bf16(y[0], y[1]); w0.y = cvt_pk_bf16(y[2], y[3]); w0.z = cvt_pk_bf16(y[4], y[5]); w0.w = cvt_pk_bf16(y[6], y[7]);
          w1.x = cvt_pk_bf16(y[8], y[9]); w1.y = cvt_pk_bf16(y[10], y[11]); w1.z = cvt_pk_bf16(y[12], y[13]); w1.w = cvt_pk_bf16(y[14], y[15]);
          *(u32x4*)dst = w0; *(u32x4*)(dst + 8) = w1;
      } }
    if (active && wid == 0) {
        float b = 0.f, gg = 0.f;
        if (lane < nvalid) { b = BG[(size_t)(row0 + lane) * 16 + h]; gg = BG[(size_t)(row0 + lane) * 16 + 8 + h]; }
#pragma unroll
        for (int o = 1; o < 64; o <<= 1) { const float t = __shfl_up(gg, o); if (lane >= o) gg += t; }
        sGam[lane] = gg; sBeta[lane] = b;
        if (lane == 63) GL[unit] = __expf(gg);
    }
    __syncthreads();
    if (active) for (int jb = wid * 8; jb < wid * 8 + 8; ++jb) {
        const int mat = jb >> 4, ti = (jb >> 2) & 3, tj = jb & 3;
        f32x4 acc = (f32x4){0.f, 0.f, 0.f, 0.f};
        if (tj <= ti) {
            const bf16_t* Y = mat == 0 ? sk : sq;
#pragma unroll
            for (int kk = 0; kk < 4; ++kk) {
                const bf16x8 xf = *(const bf16x8*)(sk + (16 * tj + fr) * 136 + 32 * kk + 8 * fq);
                const bf16x8 yf = *(const bf16x8*)(Y + (16 * ti + fr) * 136 + 32 * kk + 8 * fq);
                acc = mma(xf, yf, acc);
            }
        }
        const int i = 16 * ti + fr, j0 = 16 * tj + 4 * fq;
        const float gi = sGam[i], bi = sBeta[i];
        float zf = 0.f; asm volatile("" : "+v"(zf));
        float o[4];
#pragma unroll
        for (int jj = 0; jj < 4; ++jj) {
            const int j = j0 + jj;
            const bool keep = mat == 0 ? (j < i) : (j <= i);
            o[jj] = keep ? acc[jj] * __expf(gi - sGam[j]) * (mat == 0 ? bi : 1.0f) : zf;
        }
        if (mat == 0) *(f32x4*)(Am + i * 64 + j0) = (f32x4){o[0], o[1], o[2], o[3]};
        else { u32x2 w; w.x = cvt_pk_bf16(o[0], o[1]); w.y = cvt_pk_bf16(o[2], o[3]); *(u32x2*)(Pm + i * 64 + j0) = w; }
    }
    __syncthreads();
    if (active) {
        {
        const int part = wid >> 1, cc = tid & 127;
        const bf16_t* src = part == 0 ? sv : sk;
        bf16_t* dstb = (part == 0 ? Vb : Kb) + (size_t)row0 * 1024 + 128 * h + cc;
        float x[64];
        int zl = 0; asm volatile("" : "+v"(zl));
        solve_rows<0>(x, (const f32x4*)Am + zl, src + cc, sBeta + zl, sGam + zl, part, dstb, nvalid);
        }
        const int tt = tid;
        { const int c = tt >> 2, d0 = 32 * (tt & 3); const float eg = __expf(sGam[c]);
          if (c < nvalid) {
#pragma unroll
              for (int k = 0; k < 4; ++k) {
                  const u32x4 a = *(const u32x4*)(sq + c * 136 + d0 + 8 * k);
                  u32x4 w; w.x = cvt_pk_bf16(bflo(a.x) * eg, bfhi(a.x) * eg); w.y = cvt_pk_bf16(bflo(a.y) * eg, bfhi(a.y) * eg); w.z = cvt_pk_bf16(bflo(a.z) * eg, bfhi(a.z) * eg); w.w = cvt_pk_bf16(bflo(a.w) * eg, bfhi(a.w) * eg);
                  *(u32x4*)(Qb + (size_t)(row0 + c) * 1024 + 128 * h + d0 + 8 * k) = w;
              }
          } }
        { const int d = tt >> 1, c0 = 32 * (tt & 1); const float gl = sGam[63];
#pragma unroll
          for (int k = 0; k < 4; ++k) {
              float v[8];
#pragma unroll
              for (int i = 0; i < 8; ++i) { const int c = c0 + 8 * k + i; v[i] = bf2f(sk[c * 136 + d]) * __expf(gl - sGam[c]); }
              u32x4 w; w.x = cvt_pk_bf16(v[0], v[1]); w.y = cvt_pk_bf16(v[2], v[3]); w.z = cvt_pk_bf16(v[4], v[5]); w.w = cvt_pk_bf16(v[6], v[7]);
              *(u32x4*)(KGT + d * 64 + c0 + 8 * k) = w;
          } }
    }
    __syncthreads();
}

__device__ __forceinline__ void scan_unit(const Params& p, int g, int l, int su, unsigned char* lds, const int tidx) {
    bf16_t* ACT = (bf16_t*)(WSP() + WS_ACT);
    const bf16_t* Qg = ACT + 2 * SLOT_EL; const bf16_t* Wb = ACT + 3 * SLOT_EL; const bf16_t* Ub = ACT + 4 * SLOT_EL;
    const bf16_t* KGT = (const bf16_t*)(WSP() + WS_KGT); const bf16_t* Pm = (const bf16_t*)(WSP() + WS_P);
    bf16_t* Ob = (bf16_t*)(WSP() + WS_O); const float* GL = (const float*)(WSP() + WS_GL);
    bf16_t* sW = (bf16_t*)lds;
    bf16_t* sQ = sW + 64 * 136;
    bf16_t* sK = sQ + 64 * 136;
    bf16_t* sP = sK + 2 * 128 * 72;
    bf16_t* sST = sP + 2 * 64 * 72;
    bf16_t* sVn = sST + 64 * 136;
    const int tid = tidx, wid = __builtin_amdgcn_readfirstlane(tid >> 6), lane = tid & 63, fr = lane & 15, fq = lane >> 4;
    const bool smp = su >= 128; const int s2 = smp ? su - 128 : su;
    const int pairi = (s2 & 7) * 8 + (s2 >> 4), seq = pairi >> 3, h = pairi & 7, eq = (s2 >> 3) & 1;
    const int nsteps = smp ? 1 : 64, nvalid = smp ? 16 : 64;
    const int rowb = smp ? 32768 + 16 * seq : 4096 * seq;
    const int cid0 = smp ? 512 + seq : 64 * seq;
    const int ct = wid >> 1, ep = wid & 1;
    f32x4 accS[4];
    if (smp) {
        const float* s0 = INP(3) + (((size_t)l * 8 + seq) * 8 + h) * 16384;
#pragma unroll
        for (int e4 = 0; e4 < 4; ++e4)
#pragma unroll
            for (int j = 0; j < 4; ++j) accS[e4][j] = s0[(size_t)(16 * wid + 4 * fq + j) * 128 + 64 * eq + 16 * e4 + fr];
    } else {
#pragma unroll
        for (int e4 = 0; e4 < 4; ++e4) accS[e4] = (f32x4){0.f, 0.f, 0.f, 0.f};
    }
    u32x4 rW[2][2], rQ[2][2]; unsigned short rU[2][2][4]; float rGl[2];
    bf16x8 fK[2][2], fP[2][2];
#define SCAN_BAR() do { asm volatile("s_waitcnt lgkmcnt(0)" ::: "memory"); __builtin_amdgcn_s_barrier(); asm volatile("" ::: "memory"); } while (0)
#define SCAN_LOAD(n, S) do { const int _row = rowb + 64 * (n); const size_t _un = (size_t)(cid0 + (n)) * 8 + h; \
        _Pragma("unroll") for (int _i = 0; _i < 2; ++_i) { const int _ch = tid + 512 * _i, _c0 = _ch >> 4, _c = _c0 < nvalid ? _c0 : 0, _o = (_ch & 15) * 8;   \
            rW[S][_i] = *(const u32x4*)(Wb + (size_t)(_row + _c) * 1024 + 128 * h + _o); rQ[S][_i] = *(const u32x4*)(Qg + (size_t)(_row + _c) * 1024 + 128 * h + _o); \
            } \
        rGl[S] = GL[_un]; \
        _Pragma("unroll") for (int _t = 0; _t < 2; ++_t) _Pragma("unroll") for (int _j = 0; _j < 4; ++_j) { const int _c0 = 16 * ct + 4 * fq + _j, _c = _c0 < nvalid ? _c0 : 0; \
            rU[S][_t][_j] = Ub[(size_t)(_row + _c) * 1024 + 128 * h + 64 * eq + 16 * (2 * ep + _t) + fr]; } } while (0)
#define SCAN_STORE(n, S) do { const bool _live = (n) < nsteps; _Pragma("unroll") for (int _i = 0; _i < 2; ++_i) { const int _ch = tid + 512 * _i; const bool _ok = _live && (_ch >> 4) < nvalid; const u32x4 _z = (u32x4){0u, 0u, 0u, 0u}; \
            *(u32x4*)(sW + (_ch >> 4) * 136 + (_ch & 15) * 8) = _ok ? rW[S][_i] : _z; *(u32x4*)(sQ + (_ch >> 4) * 136 + (_ch & 15) * 8) = _ok ? rQ[S][_i] : _z; \
            } \
        _Pragma("unroll") for (int _t = 0; _t < 2; ++_t) _Pragma("unroll") for (int _j = 0; _j < 4; ++_j) uc[_t][_j] = (_live && (16 * ct + 4 * fq + _j) < nvalid) ? bf2f(rU[S][_t][_j]) : 0.f; \
        gl = _live ? rGl[S] : 1.0f; } while (0)
#define SCAN_PUT_ST() do { _Pragma("unroll") for (int e4 = 0; e4 < 4; ++e4) { u32x2 w; w.x = cvt_pk_bf16(accS[e4][0], accS[e4][1]); w.y = cvt_pk_bf16(accS[e4][2], accS[e4][3]); \
        *(u32x2*)(sST + (16 * e4 + fr) * 136 + 16 * wid + 4 * fq) = w; } } while (0)
    float uc[2][4], gl;
    const int nlast = nsteps - 1;
#define SCAN_LOADF(n, PAR) do { const size_t _un = (size_t)(cid0 + (n)) * 8 + h; _Pragma("unroll") for (int _k = 0; _k < 2; ++_k) { \
        fK[PAR][_k] = *(const bf16x8*)(KGT + _un * 8192 + (size_t)(16 * wid + fr) * 64 + 32 * _k + 8 * fq); \
        fP[PAR][_k] = *(const bf16x8*)(Pm + _un * 4096 + (size_t)(16 * ct + fr) * 64 + 32 * _k + 8 * fq); } } while (0)
    SCAN_LOAD(0, 0);
    SCAN_LOAD((1 < nlast ? 1 : nlast), 1);
    SCAN_STORE(0, 0);
    SCAN_PUT_ST();
    SCAN_LOAD((2 < nlast ? 2 : nlast), 0);
    SCAN_LOADF(0, 0);
    SCAN_LOADF((1 < nlast ? 1 : nlast), 1);
    SCAN_BAR();
#define SCAN_STEP(n, S1) do { \
        f32x4 t1[2], oacc[2]; \
        t1[0] = (f32x4){0.f, 0.f, 0.f, 0.f}; t1[1] = t1[0]; oacc[0] = t1[0]; oacc[1] = t1[0]; \
        { bf16x8 wf[4], qf[4], sf[2][4]; \
          _Pragma("unroll") for (int kk = 0; kk < 4; ++kk) { wf[kk] = *(const bf16x8*)(sW + (16 * ct + fr) * 136 + 32 * kk + 8 * fq); \
              sf[0][kk] = *(const bf16x8*)(sST + (16 * (2 * ep) + fr) * 136 + 32 * kk + 8 * fq); sf[1][kk] = *(const bf16x8*)(sST + (16 * (2 * ep + 1) + fr) * 136 + 32 * kk + 8 * fq); } \
          _Pragma("unroll") for (int kk = 0; kk < 4; ++kk) qf[kk] = *(const bf16x8*)(sQ + (16 * ct + fr) * 136 + 32 * kk + 8 * fq); \
          _Pragma("unroll") for (int kk = 0; kk < 4; ++kk) { t1[0] = mma(wf[kk], sf[0][kk], t1[0]); t1[1] = mma(wf[kk], sf[1][kk], t1[1]); } \
          _Pragma("unroll") for (int kk = 0; kk < 4; ++kk) { oacc[0] = mma(sf[0][kk], qf[kk], oacc[0]); oacc[1] = mma(sf[1][kk], qf[kk], oacc[1]); } } \
        _Pragma("unroll") for (int _t = 0; _t < 2; ++_t) { u32x2 w; w.x = cvt_pk_bf16(uc[_t][0] - t1[_t][0], uc[_t][1] - t1[_t][1]); w.y = cvt_pk_bf16(uc[_t][2] - t1[_t][2], uc[_t][3] - t1[_t][3]); \
            *(u32x2*)(sVn + (16 * (2 * ep + _t) + fr) * 72 + 16 * ct + 4 * fq) = w; } \
        SCAN_BAR(); \
        const float glc = gl; \
        SCAN_STORE((n) + 1, S1); { const int _n3 = (n) + 3 < nlast ? (n) + 3 : nlast; SCAN_LOAD(_n3, S1); } \
        _Pragma("unroll") for (int kk = 0; kk < 2; ++kk) { \
            const bf16x8 pf = fP[1 - (S1)][kk]; \
            _Pragma("unroll") for (int _t = 0; _t < 2; ++_t) { const bf16x8 vf = *(const bf16x8*)(sVn + (16 * (2 * ep + _t) + fr) * 72 + 32 * kk + 8 * fq); oacc[_t] = mma(vf, pf, oacc[_t]); } } \
        if ((n) < nsteps && 16 * ct + fr < nvalid) { _Pragma("unroll") for (int _t = 0; _t < 2; ++_t) { u32x2 w; w.x = cvt_pk_bf16(oacc[_t][0], oacc[_t][1]); w.y = cvt_pk_bf16(oacc[_t][2], oacc[_t][3]); \
            *(u32x2*)(Ob + ((((size_t)(cid0 + (n)) * 8 + h) * 2 + eq) * 64 + 16 * ct + fr) * 64 + 16 * (2 * ep + _t) + 4 * fq) = w; } } \
        _Pragma("unroll") for (int e4 = 0; e4 < 4; ++e4) accS[e4] *= glc; \
        _Pragma("unroll") for (int kk = 0; kk < 2; ++kk) { \
            const bf16x8 kf = fK[1 - (S1)][kk]; \
            _Pragma("unroll") for (int e4 = 0; e4 < 4; ++e4) { \
                const bf16x8 vf = *(const bf16x8*)(sVn + (16 * e4 + fr) * 72 + 32 * kk + 8 * fq); \
                accS[e4] = mma(kf, vf, accS[e4]); } } \
        { const int _n2 = (n) + 2 < nlast ? (n) + 2 : nlast; SCAN_LOADF(_n2, 1 - (S1)); } \
        SCAN_PUT_ST(); \
        SCAN_BAR(); } while (0)
    for (int n = 0; n < nsteps; n += 2) {
        SCAN_STEP(n, 1);
        SCAN_STEP(n + 1, 0);
    }
    __syncthreads();
#undef SCAN_STEP
#undef SCAN_PUT_ST
#undef SCAN_BAR
#undef SCAN_LOAD
#undef SCAN_LOADF
#undef SCAN_STORE
    float* dS = smp ? OUTP() + ODS + (((size_t)l * 8 + seq) * 8 + h) * 16384 : OUTP() + ODP + (((size_t)l * 16 + g * 8 + seq) * 8 + h) * 16384;
#pragma unroll
    for (int e4 = 0; e4 < 4; ++e4)
#pragma unroll
        for (int j = 0; j < 4; ++j) dS[(size_t)(16 * wid + 4 * fq + j) * 128 + 64 * eq + 16 * e4 + fr] = accS[e4][j];
}

__device__ __forceinline__ void phase_zb(const Params& p, int g, int l, int Tg, const int tidx) {
    const bf16_t* Ob = (const bf16_t*)(WSP() + WS_O); bf16_t* ZB = (bf16_t*)(WSP() + WS_ZB); const bf16_t* Zs = (const bf16_t*)(WSP() + WS_ACT) + 5 * SLOT_EL; const float* on = INP(13) + l * 128;
    const int lane16 = tidx & 15;
    const long total = (long)Tg * 8, stride = (long)gridDim.x * 32;
    const f32x4 n0 = *(const f32x4*)(on + 8 * lane16), n1 = *(const f32x4*)(on + 8 * lane16 + 4);
    for (long it0 = (long)blockIdx.x * 32 + (tidx >> 4); it0 < total; it0 += 4 * stride) {
        u32x4 av[4], zv[4]; bool okv[4]; int rv[4], hv[4];
#pragma unroll
        for (int k = 0; k < 4; ++k) {
            const long it = it0 + k * stride; const bool in = it < total;
            const int r = in ? (int)(it >> 3) : 0, h = (int)(it & 7);
            rv[k] = in ? r : -1; hv[k] = h; okv[k] = in && row_valid(g, r);
            const int rq = okv[k] ? r : 0;
            int cid, c; if (rq < 32768) { cid = rq >> 6; c = rq & 63; } else { cid = 512 + ((rq - 32768) >> 4); c = (rq - 32768) & 15; }
            av[k] = *(const u32x4*)(Ob + ((((size_t)cid * 8 + h) * 2 + (lane16 >> 3)) * 64 + c) * 64 + 8 * (lane16 & 7));
            zv[k] = *(const u32x4*)(Zs + (size_t)rq * 1024 + 128 * h + 8 * lane16);
        }
#pragma unroll
        for (int k = 0; k < 4; ++k) {
            const u32x4 a = av[k], z = zv[k];
            float v[8] = {bflo(a.x), bfhi(a.x), bflo(a.y), bfhi(a.y), bflo(a.z), bfhi(a.z), bflo(a.w), bfhi(a.w)};
            float ss = 0.f;
#pragma unroll
            for (int i = 0; i < 8; ++i) ss += v[i] * v[i];
            ss += __shfl_xor(ss, 1); ss += __shfl_xor(ss, 2); ss += __shfl_xor(ss, 4); ss += __shfl_xor(ss, 8);
            const float rstd = okv[k] ? rsqrtf(ss * (1.0f / 128.0f) + EPS) : 0.f;
            u32x4 w;
            w.x = cvt_pk_bf16(v[0] * rstd * n0[0] * bflo(z.x), v[1] * rstd * n0[1] * bfhi(z.x)); w.y = cvt_pk_bf16(v[2] * rstd * n0[2] * bflo(z.y), v[3] * rstd * n0[3] * bfhi(z.y));
            w.z = cvt_pk_bf16(v[4] * rstd * n1[0] * bflo(z.z), v[5] * rstd * n1[1] * bfhi(z.z)); w.w = cvt_pk_bf16(v[6] * rstd * n1[2] * bflo(z.w), v[7] * rstd * n1[3] * bfhi(z.w));
            if (!okv[k]) w = (u32x4){0u, 0u, 0u, 0u};
            if (rv[k] >= 0) *(u32x4*)(ZB + (size_t)rv[k] * 1024 + 128 * hv[k] + 8 * lane16) = w;
        }
    }
}

#define XB_TMO      128
#define XB_XCNT(j)  (256  + 64 * (j))
#define XB_XSUB(j)  (1280 + 64 * (j))
#define XB_XGEN(j)  (2304 + 64 * (j))
#define XB_TOP      3328
#define XB_TOPGEN   3392
#define XCD_BAR_WORDS 3456
#define XB_SPIN_CAP (1u << 20)
__device__ __forceinline__ unsigned xb_ld(unsigned* p)              { return __hip_atomic_load(p, __ATOMIC_RELAXED, __HIP_MEMORY_SCOPE_AGENT); }
__device__ __forceinline__ unsigned xb_add(unsigned* p, unsigned v) { return __hip_atomic_fetch_add(p, v, __ATOMIC_RELAXED, __HIP_MEMORY_SCOPE_AGENT); }
__device__ __forceinline__ unsigned xb_xcc_id() { return (unsigned)__builtin_amdgcn_s_getreg((3 << 11) | 20) & 0xFu; }
#define XB_SPIN(cond, bar) do { unsigned _sp = 0; while (cond) { __builtin_amdgcn_s_sleep(1); \
    if ((++_sp & 255u) == 0u) { if (xb_ld(&(bar)[XB_TMO])) break; if (_sp > XB_SPIN_CAP) { atomicAdd(&(bar)[XB_TMO], 1u); break; } } } } while (0)
__device__ __forceinline__ void xcd_barrier_complete(unsigned* bar, unsigned x, unsigned& nloc, unsigned& nx) {
    const unsigned Gt = gridDim.x;
    unsigned sum, cnt, mine, sp = 0u;
    for (;;) {
        sum = 0u; cnt = 0u; mine = 0u;
#pragma unroll
        for (unsigned j = 0; j < 16; ++j) { const unsigned c = xb_ld(&bar[XB_XCNT(j)]); sum += c; cnt += (c > 0u) ? 1u : 0u; mine = (j == x) ? c : mine; }
        if (sum == Gt) break;
        __builtin_amdgcn_s_sleep(1);
        if ((++sp & 255u) == 0u) { if (xb_ld(&bar[XB_TMO])) break; if (sp > XB_SPIN_CAP) { atomicAdd(&bar[XB_TMO], 1u); break; } }
    }
    nloc = mine > 0u ? mine : 1u; nx = cnt > 0u ? cnt : 1u;
}
__device__ __forceinline__ void grid_barrier(unsigned* bar, unsigned x, volatile unsigned* st, int tidx) {
    asm volatile("s_waitcnt vmcnt(0)" ::: "memory");
    __syncthreads();
    if (tidx == 0) {
        __builtin_amdgcn_s_waitcnt(0);
        unsigned nloc = st[0], nx = st[1];
        if (nloc == 0u) { xcd_barrier_complete(bar, x, nloc, nx); st[0] = nloc; st[1] = nx; }
        const unsigned old = xb_add(&bar[XB_XSUB(x)], 1u);
        const unsigned gen = old / nloc;
        if (old + 1u == (gen + 1u) * nloc) {
            __builtin_amdgcn_fence(__ATOMIC_RELEASE, "agent");
            asm volatile("s_waitcnt vmcnt(0)" ::: "memory");
            const unsigned og = xb_add(&bar[XB_TOP], 1u);
            const unsigned tg = og / nx;
            if (og + 1u == (tg + 1u) * nx) xb_add(&bar[XB_TOPGEN], 1u);
            else XB_SPIN(xb_ld(&bar[XB_TOPGEN]) == tg, bar);
            __builtin_amdgcn_fence(__ATOMIC_ACQUIRE, "agent");
            xb_add(&bar[XB_XGEN(x)], 1u);
            asm volatile("s_waitcnt vmcnt(0)" ::: "memory");
        } else {
            XB_SPIN(xb_ld(&bar[XB_XGEN(x)]) == gen, bar);
            __builtin_amdgcn_fence(__ATOMIC_ACQUIRE, "agent");
            asm volatile("s_waitcnt vmcnt(0)" ::: "memory");
        }
    }
    __syncthreads();
}

__global__ void __launch_bounds__(NTHREADS, 2) fwd_megakernel(Params p) {
    extern __shared__ __attribute__((aligned(16))) unsigned char lds[];
    cg::grid_group grid = cg::this_grid();
    LAS unsigned char* ldsl = (LAS unsigned char*)lds;
    bf16_t* WT = (bf16_t*)(WSP() + WS_W);
    bf16_t* XB = (bf16_t*)(WSP() + WS_XB);
    bf16_t* ACT = (bf16_t*)(WSP() + WS_ACT);
    bf16_t* Ob = (bf16_t*)(WSP() + WS_O);
    float* RSall = (float*)(WSP() + WS_RS);
    const int G = gridDim.x, bid = blockIdx.x;

    volatile unsigned* bst = (volatile unsigned*)(lds + LDS_BYTES - 16);
    if (threadIdx.x < 2) bst[threadIdx.x] = 0u;
    const unsigned xcc = xb_xcc_id();
    if (threadIdx.x == 0) (void)xb_add(&((unsigned*)(WSP() + WS_BAR))[XB_XCNT(xcc)], 1u);
    __syncthreads();
    grid.sync();
#ifndef PH_END
#define PH_END 34
#endif
    unsigned nbar = 0; int rep = 0; (void)rep;
    for (int ph = 0; ph < PH_END; ++ph) {
        int tidx = threadIdx.x; asm volatile("" : "+v"(tidx));
        int kind, g = 0, l = 0;
        if (ph == 0) kind = 0;
        else if (ph <= 16) { g = 0; l = (ph - 1) >> 3; kind = 1 + ((ph - 1) & 7); }
        else if (ph <= 32) { g = 1; l = (ph - 17) >> 3; kind = 1 + ((ph - 17) & 7); }
        else kind = 10;
        const int Tg = g == 0 ? TGMAX : 32768;
        float* RS = RSall + (size_t)(g * 5) * TGMAX;
        const bf16_t* wl = WT + (size_t)l * W_LAYER;
        if (kind == 0) { phase_wconv(p, lds, tidx); phase_s0(p, 0, TGMAX, tidx); }
        else if (kind == 10) { phase_final(p, 1, 32768, tidx); }
        else if (kind == 2) {
            const int ngm = g == 0 ? 264 : 256, nd1 = g == 0 ? NUNITS : 4096;
            if (tidx < 384) { const int X = tidx >> 7, d = tidx & 127; ((f32x4*)(lds + 139264))[tidx] = *(const f32x4*)(INP(10) + ((size_t)l * 3072 + X * 1024 + 128 * (bid & 7) + d) * 4); }
            __syncthreads();
            for (int u = bid; u < 256; u += G) gmlp_unit(p, g, l, u, lds, tidx);
            if (G >= 72) { if (ngm > 256 && bid >= 64 && bid < 64 + (ngm - 256)) gmlp_unit(p, g, l, 256 + (bid - 64), lds, tidx); }
            else for (int u = 256 + bid; u < ngm; u += G) gmlp_unit(p, g, l, u, lds, tidx);
            for (int u = bid; u < nd1; u += 2 * G) d1_unit(p, g, l, u, nd1, lds, tidx);
        } else if (kind == 3) {
            if (G == 256) {
                if (bid < 128) {
                    int nrep = 1;
#ifdef PROBE_SCAN
                    nrep = 3;
#endif
                    asm volatile("" : "+s"(nrep));
                    for (int r3 = 0; r3 < nrep + (g == 0 ? 1 : 0); ++r3) scan_unit(p, g, l, r3 < nrep ? bid : 128 + bid, lds, tidx); }
                else { pg8::Gemm gm{ACT, wl + W_PA, Tg, 1024, 1024}; pg8::StaticOrder S; S.init(Tg, 1024, 128, bid - 128); EpiT E{1, g, l, nullptr, nullptr, 0, 1}; pg8::gemm_phase<EpiT>(ldsl, gm, S, E, tidx); }
            } else {
                const int nsu = g == 0 ? 256 : 128;
                for (int u = bid; u < nsu; u += G) scan_unit(p, g, l, u, lds, tidx);
            }
        } else if (kind == 4 && G == 256) { phase_zb(p, g, l, Tg, tidx);
        } else {
            const bf16_t* A; const bf16_t* Bt; int N = 1024, K = 1024, mode; const float* rs = nullptr; float* rs_out = nullptr;
            if (kind == 1) { A = XB; Bt = wl + W_IN; N = NPROJ; mode = 0; rs = RS + (size_t)(2 * l) * TGMAX; }
            else if (kind == 4) { A = ACT; Bt = wl + W_PA; mode = 1; }
            else if (kind == 5) { A = (const bf16_t*)(WSP() + WS_ZB); Bt = wl + W_PB; mode = 2; }
            else if (kind == 6) { A = ACT + 7 * SLOT_EL; Bt = wl + W_WO; mode = 4; rs_out = RS + (size_t)(2 * l + 1) * TGMAX; }
            else if (kind == 7) { A = XB; Bt = wl + W_UP; N = DFF; mode = 3; rs = RS + (size_t)(2 * l + 1) * TGMAX; }
            else { A = ACT; Bt = wl + W_DN; K = DFF; mode = 4; rs_out = RS + (size_t)(2 * l + 2) * TGMAX; }
            pg8::Gemm gm{A, Bt, Tg, N, K}; pg8::StaticOrder S; S.init(Tg, N, G, bid);
            EpiT E{mode, g, l, rs, rs_out, (kind == 6 && l == 0) ? 1 : 0, (kind == 8 && l == 1) ? 0 : 1};
            pg8::gemm_phase<EpiT>(ldsl, gm, S, E, tidx);
            if (kind == 4) phase_zb(p, g, l, Tg, tidx);
            if (kind == 8 && g == 0 && l == 1) phase_s0(p, 1, 32768, tidx);
            if (kind == 1 && g == 1 && l == 0) phase_final(p, 0, TGMAX, tidx);
        }
        if (ph < PH_END - 1) { ++nbar; grid_barrier((unsigned*)(WSP() + WS_BAR), xcc, bst, tidx); }
#ifdef PROBE_BAR
        if (ph < PH_END - 1) { for (int xb = 0; xb < 2; ++xb) { ++nbar; grid_barrier((unsigned*)(WSP() + WS_BAR), xcc, bst, tidx); } }
#endif
#ifdef PROBE_KINDS
        if (rep == 0 && ((PROBE_KINDS >> kind) & 1)) { rep = 1; --ph; } else rep = 0;
#endif
    }
}

extern "C" void kernel_launch(void* const* d_in, const int* in_sizes, int n_in, void* d_out, int out_size, void* d_ws, size_t ws_size, hipStream_t stream) {
    static int grid_blocks = 0;
    if (!grid_blocks) {
        int dev = 0, cus = 0, per_cu = 0;
        hipGetDevice(&dev);
        hipDeviceGetAttribute(&cus, hipDeviceAttributeMultiprocessorCount, dev);
        if (hipFuncSetAttribute((const void*)fwd_megakernel, hipFuncAttributeMaxDynamicSharedMemorySize, LDS_BYTES) != hipSuccess) fprintf(stderr, "hipFuncSetAttribute failed\n");
        hipOccupancyMaxActiveBlocksPerMultiprocessor(&per_cu, (const void*)fwd_megakernel, NTHREADS, LDS_BYTES);
        if (per_cu < 1) per_cu = 1;
        grid_blocks = cus * 1;
        (void)hipGetLastError();
        if (ws_size < WS_END) fprintf(stderr, "workspace too small: %zu < %zu\n", ws_size, (size_t)WS_END);
    }
    Params p{};
    for (int i = 0; i < 21; ++i) p.in[i] = (const float*)d_in[i];
    p.out = (float*)d_out; p.ws = (unsigned char*)d_ws;
    (void)hipMemsetAsync((unsigned char*)d_ws + WS_BAR, 0, 16384, stream);
    void* args[] = {&p};
    hipError_t e = hipLaunchCooperativeKernel((void*)fwd_megakernel, dim3(grid_blocks), dim3(NTHREADS), args, LDS_BYTES, stream);
    if (e != hipSuccess) fprintf(stderr, "cooperative launch failed: %s (grid %d)\n", hipGetErrorString(e), grid_blocks);
}
```
